# Optimizing an MI355X kernel written in HIP

```python
import jax, jax.numpy as jnp
from jax import lax
import numpy as np

D_MODEL = 1024
BATCH = 8
SEQ = 4096
DEPTH = 2

EXPAND = 2
D_INNER = EXPAND * D_MODEL
N_GROUPS = 8
GROUP_DIM = D_INNER // N_GROUPS
CHUNK = 128
N_MIXERS = 2
EPS = 1e-6

kernel_name = "hybrid_fourier_sgu_encoder"


def rms_norm(x, g):
    xf = x.astype(jnp.float32)
    y = xf * lax.rsqrt(jnp.mean(xf * xf, axis=-1, keepdims=True) + EPS)
    return (y * g.astype(jnp.float32)).astype(x.dtype)


def layer_norm(x, g, b):
    xf = x.astype(jnp.float32)
    mu = jnp.mean(xf, axis=-1, keepdims=True)
    var = jnp.mean(jnp.square(xf - mu), axis=-1, keepdims=True)
    y = (xf - mu) * lax.rsqrt(var + EPS)
    return (y * g.astype(jnp.float32) + b.astype(jnp.float32)).astype(x.dtype)


def fourier_mixer(h, w_in, w_out):
    b, s, _ = h.shape
    proj = h @ w_in
    xin, z = proj[..., :D_INNER], proj[..., D_INNER:]
    xg = xin.reshape(b, s, N_GROUPS, GROUP_DIM).astype(jnp.float32)
    y = jnp.fft.fft2(xg, axes=(1, 3), norm="ortho").real
    y = y.astype(h.dtype).reshape(b, s, D_INNER)
    return (y * jax.nn.silu(z)) @ w_out


def sgu_mixer(h, w_in, v_ln_g, v_ln_b, w_s, b_s, w_out):
    b, s, _ = h.shape
    proj = h @ w_in
    uv = jax.nn.gelu(proj[..., :2 * D_INNER])
    z = proj[..., 2 * D_INNER:]
    u, v = uv[..., :D_INNER], uv[..., D_INNER:]
    v = layer_norm(v, v_ln_g, v_ln_b)
    v = v.reshape(b, s // CHUNK, CHUNK, N_GROUPS, GROUP_DIM)
    v = jnp.einsum('gpq,bnqgc->bnpgc', w_s, v) + b_s.T[None, None, :, :, None]
    y = u * v.reshape(b, s, D_INNER)
    return (y * jax.nn.silu(z)) @ w_out


def setup_inputs(seed: int = 0) -> dict:
    key = jax.random.key(seed)
    ks = jax.random.split(key, 12)
    f32 = jnp.float32
    d, e = D_MODEL, D_INNER
    return {
        "x": jax.random.normal(ks[0], (BATCH, SEQ, d), f32),
        "l0_norm": 1.0 + 0.02 * jax.random.normal(ks[1], (d,), f32),
        "l0_w_in": jax.random.normal(ks[2], (d, 2 * e), f32) * d ** -0.5,
        "l0_w_out": jax.random.normal(ks[3], (e, d), f32) * e ** -0.5,
        "l1_norm": 1.0 + 0.02 * jax.random.normal(ks[4], (d,), f32),
        "l1_w_in": jax.random.normal(ks[5], (d, 3 * e), f32) * d ** -0.5,
        "l1_v_ln_g": 1.0 + 0.02 * jax.random.normal(ks[6], (e,), f32),
        "l1_v_ln_b": 0.02 * jax.random.normal(ks[7], (e,), f32),
        "l1_w_s": jax.random.normal(ks[8], (N_GROUPS, CHUNK, CHUNK), f32) * CHUNK ** -0.5,
        "l1_b_s": 1.0 + 0.02 * jax.random.normal(ks[9], (N_GROUPS, CHUNK), f32),
        "l1_w_out": jax.random.normal(ks[10], (e, d), f32) * e ** -0.5,
        "final_norm": 1.0 + 0.02 * jax.random.normal(ks[11], (d,), f32),
    }


def reference(x, l0_norm, l0_w_in, l0_w_out, l1_norm, l1_w_in, l1_v_ln_g, l1_v_ln_b,
              l1_w_s, l1_b_s, l1_w_out, final_norm):
    mixers = [fourier_mixer, sgu_mixer]
    norms = [l0_norm, l1_norm]
    params = [
        (l0_w_in, l0_w_out),
        (l1_w_in, l1_v_ln_g, l1_v_ln_b, l1_w_s, l1_b_s, l1_w_out),
    ]
    for i in range(DEPTH):
        h = rms_norm(x, norms[i])
        x = x + mixers[i % N_MIXERS](h, *params[i])
    return rms_norm(x, final_norm)
```

```cpp
#include <hip/hip_runtime.h>
#include <hip/hip_cooperative_groups.h>
#include <cstdio>
#include <cstdint>
namespace cg = cooperative_groups;

#define LAS __attribute__((address_space(3)))
typedef unsigned short bf16_t;
typedef short bf16x8 __attribute__((ext_vector_type(8)));
typedef float f32x4 __attribute__((ext_vector_type(4)));
typedef float f32x2 __attribute__((ext_vector_type(2)));
typedef unsigned u32x4 __attribute__((ext_vector_type(4)));
typedef unsigned u32x2 __attribute__((ext_vector_type(2)));

constexpr int MROWS = 32768, DM = 1024, EI = 2048, SEQ = 4096;
constexpr float EPS = 1e-6f;
constexpr int NTHREADS = 512, NWAVES = 8;
constexpr int LDS_BYTES = 148480;
constexpr size_t MiB = 1u << 20;
constexpr size_t WS_SS1 = 0, WS_VSUM = 128 * 1024, WS_VSQ = 256 * 1024, WS_SS2 = 384 * 1024;
constexpr size_t WS_W0T = 1 * MiB, WS_WO0T = 9 * MiB, WS_W1T = 13 * MiB, WS_WO1T = 25 * MiB;
constexpr size_t WS_HB = 32 * MiB, WS_BUFA = 96 * MiB, WS_BUFB = 224 * MiB, WS_BUFC = 352 * MiB, WS_END = 480 * MiB;

__device__ __forceinline__ unsigned cvt_pk_bf16(float lo, float hi) { unsigned r; asm volatile("v_cvt_pk_bf16_f32 %0, %1, %2" : "=v"(r) : "v"(lo), "v"(hi)); return r; }
__device__ __forceinline__ float bf_lo(unsigned u) { return __uint_as_float(u << 16); }
__device__ __forceinline__ float bf_hi(unsigned u) { return __uint_as_float(u & 0xffff0000u); }
__device__ __forceinline__ float silu_f(float x) { return x * __builtin_amdgcn_rcpf(1.0f + __builtin_amdgcn_exp2f(-1.4426950409f * x)); }
__device__ __forceinline__ float gelu_f(float x) { const float t = x * (1.0f + 0.044715f * x * x); return x * __builtin_amdgcn_rcpf(1.0f + __builtin_amdgcn_exp2f(-2.302208198f * t)); }
__device__ __forceinline__ float wave_sum(float v) {
#pragma unroll
    for (int o = 1; o < 64; o <<= 1) v += __shfl_xor(v, o);
    return v;
}
__host__ __device__ __forceinline__ int chan_of_pos(int p) { const int s = p >> 4, e = p & 15; if (e < 8) return 8 * s + e; const int j = 8 * s + (e - 8); return j == 0 ? 128 : 256 - j; }
__host__ __device__ __forceinline__ int pos_of_chan(int ch) { if (ch < 128) return 16 * (ch >> 3) + (ch & 7); if (ch == 128) return 8; const int j = 256 - ch; return 16 * (j >> 3) + 8 + (j & 7); }

namespace pg8 {
constexpr int BM = 256, BK = 64, HALF = 128, HTB = HALF * BK * 2, STAGE_BYTES = 8 * HTB, NXCD = 8, WGM = 8;
__host__ __device__ __forceinline__ int lds_byte(int r, int c) { const int st = (r >> 4) * 2 + (c >> 5), rr = r & 15, cc = c & 31, ob = rr * 64 + cc * 2; return st * 1024 + (ob ^ (((ob >> 9) & 1) << 5)); }
__host__ __device__ __forceinline__ void stage_rc(int b, int& R, int& C) { const int st = b / 1024, sb = b % 1024, swz = sb ^ (((sb >> 9) & 1) << 5); R = (st >> 1) * 16 + swz / 64; C = (st & 1) * 32 + (swz % 64) / 2; }
__host__ __device__ __forceinline__ int perm32(int rho) { const int n = rho >> 4, i = rho & 15; return 8 * (i >> 2) + 4 * n + (i & 3); }
struct Unit { int pm, pn; };
struct Gemm { const bf16_t* A; const bf16_t* Bt; int M, N, K; };
struct StaticOrder {
    int nM, nN, nwg, G, c;
    __host__ __device__ void init(int M, int N, int G_, int c_) { nM = M / BM; nN = N / BM; nwg = nM * nN; G = G_; c = c_; }
    __host__ __device__ bool next(int i, Unit& u) const {
        const long L = (long)i * G + c; if (L >= nwg) return false;
        int wgid = (int)L; { const int q = nwg / NXCD, r = nwg % NXCD, xcd = wgid % NXCD, off = wgid / NXCD; wgid = (xcd < r ? xcd * (q + 1) : r * (q + 1) + (xcd - r) * q) + off; }
        const int nig = WGM * nN, gid = wgid / nig, fm = gid * WGM, gsz = (nM - fm) < WGM ? (nM - fm) : WGM;
        u.pm = fm + ((wgid % nig) % gsz); u.pn = (wgid % nig) / gsz; return true;
    }
};
template <class Epi, bool ABLK>
__device__ __forceinline__ void gemm_phase(LAS unsigned char* lds, const Gemm g, const StaticOrder& S, const Epi& E) {
    const int tid = threadIdx.x, wid = __builtin_amdgcn_readfirstlane(tid >> 6), lane = tid & 63, wr = wid >> 2, wc = wid & 3, fr = lane & 15, fq = lane >> 4;
    const int K = g.K, nt = K / BK;
    unsigned voffA[2], voffB[2];
#pragma unroll
    for (int i = 0; i < 2; ++i) { int R, C; stage_rc(tid * 16 + i * 8192, R, C); const int Rb = (R & ~31) + perm32(R & 31);
        voffA[i] = ABLK ? (unsigned)((C >> 4) * 65536 + R * 16 + (C & 15)) * 2u : (unsigned)(R * K + C) * 2u; voffB[i] = (unsigned)(Rb * K + C) * 2u; }
    const size_t kstepB = (size_t)(BK * 2), hstepB = (size_t)HALF * K * 2, tstepB = 2 * hstepB;
    const size_t kstepA = ABLK ? (size_t)4 * 65536 * 2 : kstepB, hstepA = ABLK ? (size_t)HALF * 16 * 2 : hstepB;
#define PG8_ABASE(pm) ((const char*)g.A + (ABLK ? ((size_t)((pm) >> 4) * 4096 * 2048 + (size_t)((pm) & 15) * 256 * 16) * 2 : (size_t)(pm) * tstepB))
    const unsigned ldsw = (unsigned)wid * 1024u;
    const int aoff = lds_byte(wr * 64 + fr, fq * 8), boff = lds_byte(wc * 32 + fr, fq * 8);
#define PG8_SA(b, h) (((b) * 2 + (h)) * HTB)
#define PG8_SB(b, h) ((4 + (b) * 2 + (h)) * HTB)
#define PG8_STAGE(bufoff, gbase, voff) do { _Pragma("unroll") for (int _i = 0; _i < 2; ++_i) \
        __builtin_amdgcn_global_load_lds((const unsigned*)((const char*)(gbase) + (voff)[_i]), (LAS unsigned*)(lds + (bufoff) + ldsw + _i * 8192), 16, 0, 0); } while (0)
#define PG8_LDA(dst, b, h) do { _Pragma("unroll") for (int m = 0; m < 4; ++m) _Pragma("unroll") for (int k = 0; k < 2; ++k) dst[m][k] = *(const LAS bf16x8*)(lds + PG8_SA(b, h) + aoff + m * 2048 + k * 1024); } while (0)
#define PG8_LDB(dst, b, h) do { _Pragma("unroll") for (int n = 0; n < 2; ++n) _Pragma("unroll") for (int k = 0; k < 2; ++k) dst[n][k] = *(const LAS bf16x8*)(lds + PG8_SB(b, h) + boff + n * 2048 + k * 1024); } while (0)
#define PG8_MMA(ai, bj, At, Bt) do { __builtin_amdgcn_s_setprio(1); _Pragma("unroll") for (int m = 0; m < 4; ++m) _Pragma("unroll") for (int n = 0; n < 2; ++n) _Pragma("unroll") for (int k = 0; k < 2; ++k) \
        acc[ai][bj][m][n] = __builtin_amdgcn_mfma_f32_16x16x32_bf16(Bt[n][k], At[m][k], acc[ai][bj][m][n], 0, 0, 0); __builtin_amdgcn_s_setprio(0); } while (0)
#define PG8_WAIT_V(n) asm volatile("s_waitcnt vmcnt(" #n ")" ::: "memory")
#define PG8_WAIT_L(n) asm volatile("s_waitcnt lgkmcnt(" #n ")" ::: "memory")
#define PG8_BAR __builtin_amdgcn_s_barrier()
#define PG8_SCHED __builtin_amdgcn_sched_barrier(0)
    Unit cur, nxt; int ui = 0;
    if (!S.next(0, cur)) return;
    f32x4 acc[2][2][4][2];
#pragma unroll
    for (int a = 0; a < 2; ++a)
#pragma unroll
        for (int b = 0; b < 2; ++b)
#pragma unroll
            for (int m = 0; m < 4; ++m)
#pragma unroll
                for (int n = 0; n < 2; ++n) acc[a][b][m][n] = (f32x4){0.f, 0.f, 0.f, 0.f};
    bf16x8 At[4][2], B0[2][2], B1[2][2];
    const char* cA = PG8_ABASE(cur.pm); const char* cB = (const char*)g.Bt + (size_t)cur.pn * tstepB;
    PG8_STAGE(PG8_SB(0, 0), cB, voffB); PG8_STAGE(PG8_SB(0, 1), cB + hstepB, voffB); PG8_STAGE(PG8_SA(0, 0), cA, voffA); PG8_STAGE(PG8_SA(0, 1), cA + hstepA, voffA);
    if (wr == 1) PG8_BAR;
    PG8_WAIT_V(2); PG8_BAR;
    PG8_STAGE(PG8_SB(1, 0), cB + kstepB, voffB); PG8_STAGE(PG8_SA(1, 0), cA + kstepA, voffA); PG8_STAGE(PG8_SB(1, 1), cB + hstepB + kstepB, voffB);
    PG8_WAIT_V(6); PG8_BAR;
    for (;;) {
        const bool has_next = S.next(ui + 1, nxt);
        const char* nA = has_next ? PG8_ABASE(nxt.pm) : cA; const char* nB = has_next ? (const char*)g.Bt + (size_t)nxt.pn * tstepB : cB;
        for (int t = 0; t < nt; t += 2) {
            const bool last = (t == nt - 2);
            const char* a1 = cA + (size_t)(t + 1) * kstepA;
            const char* a2 = last ? nA : cA + (size_t)(t + 2) * kstepA; const char* b2 = last ? nB : cB + (size_t)(t + 2) * kstepB;
            const char* a3 = a2 + kstepA; const char* b3 = b2 + kstepB;
            PG8_LDB(B0, 0, 0); PG8_LDB(B1, 0, 1); PG8_SCHED; PG8_LDA(At, 0, 0); PG8_STAGE(PG8_SA(1, 1), a1 + hstepA, voffA);
            PG8_WAIT_V(8); PG8_WAIT_L(0); PG8_BAR; PG8_MMA(0, 0, At, B0); PG8_MMA(0, 1, At, B1); PG8_BAR; PG8_SCHED;
            PG8_LDA(At, 0, 1); PG8_STAGE(PG8_SB(0, 0), b2, voffB); PG8_STAGE(PG8_SB(0, 1), b2 + hstepB, voffB); PG8_STAGE(PG8_SA(0, 0), a2, voffA);
            PG8_WAIT_V(8); PG8_WAIT_L(0); PG8_BAR; PG8_MMA(1, 0, At, B0); PG8_MMA(1, 1, At, B1); PG8_BAR; PG8_SCHED;
            PG8_LDB(B0, 1, 0); PG8_LDB(B1, 1, 1); PG8_SCHED; PG8_LDA(At, 1, 0); PG8_STAGE(PG8_SA(0, 1), a2 + hstepA, voffA);
            PG8_WAIT_V(8); PG8_WAIT_L(0); PG8_BAR; PG8_MMA(0, 0, At, B0); PG8_MMA(0, 1, At, B1); PG8_BAR; PG8_SCHED;
            PG8_LDA(At, 1, 1); PG8_STAGE(PG8_SB(1, 0), b3, voffB); PG8_STAGE(PG8_SB(1, 1), b3 + hstepB, voffB); PG8_STAGE(PG8_SA(1, 0), a3, voffA);
            PG8_WAIT_V(8); PG8_WAIT_L(0); PG8_BAR; PG8_MMA(1, 0, At, B0); PG8_MMA(1, 1, At, B1); PG8_BAR; PG8_SCHED;
        }
        if (wr == 0) PG8_BAR;
        E(acc, cur, wr, wc, fr, fq);
        if (!has_next) break;
#pragma unroll
        for (int a = 0; a < 2; ++a)
#pragma unroll
            for (int b = 0; b < 2; ++b)
#pragma unroll
                for (int m = 0; m < 4; ++m)
#pragma unroll
                    for (int n = 0; n < 2; ++n) acc[a][b][m][n] = (f32x4){0.f, 0.f, 0.f, 0.f};
        cur = nxt; cA = nA; cB = nB; ++ui;
        if (wr == 1) PG8_BAR;
    }
    PG8_WAIT_V(0);
    PG8_BAR;
#undef PG8_ABASE
#undef PG8_SA
#undef PG8_SB
#undef PG8_STAGE
#undef PG8_LDA
#undef PG8_LDB
#undef PG8_MMA
#undef PG8_WAIT_V
#undef PG8_WAIT_L
#undef PG8_BAR
#undef PG8_SCHED
}
}

__device__ __forceinline__ u32x4 pack8(const f32x4 v0, const f32x4 v1) { u32x4 w; w.x = cvt_pk_bf16(v0[0], v0[1]); w.y = cvt_pk_bf16(v0[2], v0[3]); w.z = cvt_pk_bf16(v1[0], v1[1]); w.w = cvt_pk_bf16(v1[2], v1[3]); return w; }

struct Epi1 {
    bf16_t* Z; bf16_t* SZ;
    __device__ __forceinline__ void operator()(const f32x4 (&acc)[2][2][4][2], const pg8::Unit& u, int wr, int wc, int fr, int fq) const {
        const int b = u.pm >> 4, t0 = (u.pm & 15) * 256 + wr * 64 + fr; const bool gate = u.pn >= 8; const int g = u.pn & 7;
        bf16_t* base = (gate ? SZ : Z) + (size_t)(b * 8 + g) * (16 * 4096 * 16);
#pragma unroll
        for (int ai = 0; ai < 2; ++ai)
#pragma unroll
            for (int m = 0; m < 4; ++m) { const int t = t0 + ai * 128 + m * 16;
#pragma unroll
                for (int bj = 0; bj < 2; ++bj) { const int cgp = bj * 128 + wc * 32 + fq * 8, s = cgp >> 4, e0 = cgp & 8;
                    f32x4 v0 = acc[ai][bj][m][0], v1 = acc[ai][bj][m][1];
                    if (gate) {
#pragma unroll
                        for (int j = 0; j < 4; ++j) { v0[j] = silu_f(v0[j]); v1[j] = silu_f(v1[j]); } }
                    *(u32x4*)(base + ((size_t)s * 4096 + t) * 16 + e0) = pack8(v0, v1); } }
    }
};
template <bool WB> struct EpiRes {
    const float* XIN; float* XO; bf16_t* XB; float* SS;
    __device__ __forceinline__ void operator()(const f32x4 (&acc)[2][2][4][2], const pg8::Unit& u, int wr, int wc, int fr, int fq) const {
        const int row0 = u.pm * 256 + wr * 64 + fr, col0 = u.pn * 256 + wc * 32 + fq * 8;
#pragma unroll
        for (int ai = 0; ai < 2; ++ai)
#pragma unroll
            for (int m = 0; m < 4; ++m) { const int row = row0 + ai * 128 + m * 16; float ss = 0.f;
#pragma unroll
                for (int bj = 0; bj < 2; ++bj) { const size_t off = (size_t)row * DM + col0 + bj * 128;
                    const f32x4 x0 = *(const f32x4*)(XIN + off), x1 = *(const f32x4*)(XIN + off + 4);
                    const f32x4 v0 = acc[ai][bj][m][0] + x0, v1 = acc[ai][bj][m][1] + x1;
                    *(f32x4*)(XO + off) = v0; *(f32x4*)(XO + off + 4) = v1;
                    if (WB) *(u32x4*)(XB + off) = pack8(v0, v1);
                    ss += (v0[0] * v0[0] + v0[1] * v0[1]) + (v0[2] * v0[2] + v0[3] * v0[3]) + (v1[0] * v1[0] + v1[1] * v1[1]) + (v1[2] * v1[2] + v1[3] * v1[3]); }
                ss += __shfl_xor(ss, 16); ss += __shfl_xor(ss, 32);
                if (fq == 0) atomicAdd(SS + row, ss); }
    }
};
struct Epi3 {
    const float* SS1; bf16_t* U; float* VSUM; float* VSQ;
    __device__ __forceinline__ void operator()(const f32x4 (&acc)[2][2][4][2], const pg8::Unit& u, int wr, int wc, int fr, int fq) const {
        const int row0 = u.pm * 256 + wr * 64 + fr, which = u.pn >> 3, col0 = (u.pn & 7) * 256 + wc * 32 + fq * 8;
        bf16_t* dst = U + (size_t)which * ((WS_BUFB - WS_BUFA) / 2);
#pragma unroll
        for (int ai = 0; ai < 2; ++ai)
#pragma unroll
            for (int m = 0; m < 4; ++m) { const int row = row0 + ai * 128 + m * 16;
                const float rs = __builtin_amdgcn_rsqf(SS1[row] * (1.0f / DM) + EPS); float s1 = 0.f, s2 = 0.f;
#pragma unroll
                for (int bj = 0; bj < 2; ++bj) { f32x4 v0 = acc[ai][bj][m][0] * rs, v1 = acc[ai][bj][m][1] * rs;
                    if (which == 2) {
#pragma unroll
                        for (int j = 0; j < 4; ++j) { v0[j] = silu_f(v0[j]); v1[j] = silu_f(v1[j]); } }
                    else {
#pragma unroll
                        for (int j = 0; j < 4; ++j) { v0[j] = gelu_f(v0[j]); v1[j] = gelu_f(v1[j]); } }
                    if (which == 1) { s1 += (v0[0] + v0[1]) + (v0[2] + v0[3]) + (v1[0] + v1[1]) + (v1[2] + v1[3]);
                        s2 += (v0[0] * v0[0] + v0[1] * v0[1]) + (v0[2] * v0[2] + v0[3] * v0[3]) + (v1[0] * v1[0] + v1[1] * v1[1]) + (v1[2] * v1[2] + v1[3] * v1[3]); }
                    *(u32x4*)(dst + (size_t)row * EI + col0 + bj * 128) = pack8(v0, v1); }
                if (which == 1) { s1 += __shfl_xor(s1, 16); s1 += __shfl_xor(s1, 32); s2 += __shfl_xor(s2, 16); s2 += __shfl_xor(s2, 32);
                    if (fq == 0) { atomicAdd(VSUM + row, s1); atomicAdd(VSQ + row, s2); } } }
    }
};

struct Args { const float* in[12]; float* out; unsigned char* ws; };
struct Frame {
    LAS unsigned char* lds; int tid, lane, wave, G, bx;
    const float *x, *n0, *win0, *wout0, *n1, *win1, *lng, *lnb, *wsp, *bsp, *wout1, *nf; float* out;
    float *ss1, *vsum, *vsq, *ss2;
    bf16_t *W0t, *Wo0t, *W1t, *Wo1t, *HB, *BA, *BB, *BC;
};

__device__ __forceinline__ void p0_transpose_item(const float* W, int N, bf16_t* WT, int Kd, LAS float* scr, int k0, int n0, int lane, int mode, const float* kscale) {
#pragma unroll 8
    for (int i = 0; i < 32; ++i) { const int kk = 2 * i + (lane >> 5), k = k0 + kk; const int sr = (mode == 2) ? ((k & ~255) + chan_of_pos(k & 255)) : k;
        float v = W[(size_t)sr * N + n0 + (lane & 31)]; if (mode == 3) v *= kscale[k]; scr[kk * 33 + (lane & 31)] = v; }
    asm volatile("s_waitcnt lgkmcnt(0)" ::: "memory");
    const int c = lane & 7;
#pragma unroll
    for (int j = 0; j < 4; ++j) { const int n = (lane >> 3) + 8 * j; const LAS float* s = scr + (8 * c) * 33 + n; const int ns = n0 + n;
        const int dr = (mode == 1) ? (2048 + (ns & 0x700) + pos_of_chan(ns & 255)) : ns;
        u32x4 o; o.x = cvt_pk_bf16(s[0 * 33], s[1 * 33]); o.y = cvt_pk_bf16(s[2 * 33], s[3 * 33]); o.z = cvt_pk_bf16(s[4 * 33], s[5 * 33]); o.w = cvt_pk_bf16(s[6 * 33], s[7 * 33]);
        *(u32x4*)(WT + (size_t)dr * Kd + k0 + 8 * c) = o; }
    asm volatile("s_waitcnt lgkmcnt(0)" ::: "memory");
}
__device__ __forceinline__ void p0_prep(Frame& F) {
    LAS float* scr = (LAS float*)(F.lds + F.wave * 16384);
    LAS float* costab = (LAS float*)(F.lds + 131072);
    if (F.tid < 256) costab[F.tid] = cospif((float)F.tid * (1.0f / 128.0f)) * (1.0f / 16.0f);
    __syncthreads();
    const int gw = F.bx * NWAVES + F.wave, NGW = F.G * NWAVES;
    for (int i = F.bx * NTHREADS + F.tid; i < 4 * MROWS; i += F.G * NTHREADS) F.ss1[i] = 0.f;
    constexpr int I_A = 16 * 64, I_B = 32 * 32, I_C = 16 * 192, I_D = 32 * 32;
    for (int it = gw; it < I_A + I_B + I_C + I_D; it += NGW) {
        int r = it;
        if (r < I_A) { const int kb = r >> 6, nb = r & 63; p0_transpose_item(F.win0, 4096, F.W0t, 1024, scr, kb * 64, 2048 + nb * 32, F.lane, 1, nullptr); continue; } r -= I_A;
        if (r < I_B) { const int kb = r >> 5, nb = r & 31; p0_transpose_item(F.wout0, 1024, F.Wo0t, 2048, scr, kb * 64, nb * 32, F.lane, 2, nullptr); continue; } r -= I_B;
        if (r < I_C) { const int kb = r / 192, nb = r % 192; p0_transpose_item(F.win1, 6144, F.W1t, 1024, scr, kb * 64, nb * 32, F.lane, 3, F.n1); continue; } r -= I_C;
        { const int kb = r >> 5, nb = r & 31; p0_transpose_item(F.wout1, 1024, F.Wo1t, 2048, scr, kb * 64, nb * 32, F.lane, 0, nullptr); }
    }
    for (int task = gw; task < 4096; task += NGW) {
        const int kb = task >> 5, g = (task >> 2) & 7, pc = task & 3, P = pc * 64 + F.lane;
        const int jeff = (P == 1) ? 128 : (P >> 1), phase = (P >= 3 && (P & 1)) ? 64 : 0;
        const float* wp = F.win0 + (size_t)(kb * 8) * 4096 + g * 256;
#pragma unroll
        for (int i = 0; i < 8; ++i) *(LAS f32x4*)(scr + i * 256 + F.lane * 4) = *(const f32x4*)(wp + (size_t)i * 4096 + F.lane * 4);
        asm volatile("s_waitcnt vmcnt(0) lgkmcnt(0)" ::: "memory");
        float a[8];
#pragma unroll
        for (int i = 0; i < 8; ++i) a[i] = 0.f;
        for (int c = 0; c < 256; c += 4) {
            float t[4];
#pragma unroll
            for (int j = 0; j < 4; ++j) t[j] = costab[(jeff * (c + j) + phase) & 255];
#pragma unroll
            for (int i = 0; i < 8; ++i) { const f32x4 w = *(const LAS f32x4*)(scr + i * 256 + c); a[i] += w[0] * t[0]; a[i] += w[1] * t[1]; a[i] += w[2] * t[2]; a[i] += w[3] * t[3]; }
        }
        u32x4 o; o.x = cvt_pk_bf16(a[0], a[1]); o.y = cvt_pk_bf16(a[2], a[3]); o.z = cvt_pk_bf16(a[4], a[5]); o.w = cvt_pk_bf16(a[6], a[7]);
        *(u32x4*)(F.W0t + (size_t)(g * 256 + P) * 1024 + kb * 8) = o;
        asm volatile("s_waitcnt lgkmcnt(0)" ::: "memory");
    }
    for (int m = gw; m < MROWS; m += NGW) {
        const f32x4* xr = (const f32x4*)(F.x + (size_t)m * DM) + F.lane; const f32x4* gr = (const f32x4*)F.n0 + F.lane;
        f32x4 v[4]; float s = 0.f;
#pragma unroll
        for (int j = 0; j < 4; ++j) { v[j] = xr[64 * j]; s += (v[j][0] * v[j][0] + v[j][1] * v[j][1]) + (v[j][2] * v[j][2] + v[j][3] * v[j][3]); }
        const float rstd = 1.0f / sqrtf(wave_sum(s) * (1.0f / DM) + EPS);
        u32x2* o8 = (u32x2*)(F.HB + (size_t)m * DM) + F.lane;
#pragma unroll
        for (int j = 0; j < 4; ++j) { const f32x4 gg = gr[64 * j]; u32x2 w; w.x = cvt_pk_bf16(v[j][0] * rstd * gg[0], v[j][1] * rstd * gg[1]); w.y = cvt_pk_bf16(v[j][2] * rstd * gg[2], v[j][3] * rstd * gg[3]); o8[64 * j] = w; }
    }
}

__device__ __forceinline__ bf16x8 rot_negre(const bf16x8 x) {
    u32x4 d = __builtin_bit_cast(u32x4, x);
#pragma unroll
    for (int i = 0; i < 4; ++i) d[i] = __builtin_amdgcn_alignbit(d[i], d[i], 16) ^ 0x80000000u;
    return __builtin_bit_cast(bf16x8, d);
}
__device__ __forceinline__ int f3swz(int R3) { return (R3 & 8) | ((R3 & 7) ^ ((R3 >> 3) & 7)); }
__device__ __forceinline__ void p2_fft(Frame& F) {
    LAS unsigned char* D = F.lds; LAS unsigned char* CM = F.lds + 131072;
    const int tid = F.tid, lane = F.lane, w = F.wave, fr = lane & 15, fq = lane >> 4;
    for (int e = tid; e < 4096; e += NTHREADS) { const int k = e >> 6, n = e & 63; float s, c; sincospif((float)((k * n) & 63) * (1.0f / 32.0f), &s, &c);
        *(LAS unsigned*)(CM + k * 256 + (((n >> 2) ^ (k & 15)) * 16) + (n & 3) * 4) = cvt_pk_bf16(c * 0.125f, s * 0.125f); }
    __syncthreads();
    for (int item = F.bx; item < 1024; item += F.G) {
        int lanev = lane; asm volatile("" : "+v"(lanev));
        const int frv = lanev & 15, fqv = lanev >> 4, tidv = w * 64 + lanev;
        const int bg = item >> 4, slab = item & 15;
        const size_t ibase = ((size_t)bg * 16 + slab) * (4096 * 16);
        const bf16_t* Zs = F.BA + ibase; const bf16_t* Gs = F.BB + ibase; bf16_t* Ys = F.BC + ibase;
        { const int half = lanev & 1, n2 = w * 8 + ((lanev >> 1) & 7), n1l = (lanev >> 4) & 3;
            u32x4 v[16];
#pragma unroll
            for (int i = 0; i < 16; ++i) { const int tok = (i * 4 + n1l) * 64 + n2; v[i] = *(const u32x4*)(Zs + tok * 16 + half * 8); }
#pragma unroll
            for (int i = 0; i < 16; ++i) { const int n1 = i * 4 + n1l;
#pragma unroll
                for (int d = 0; d < 4; ++d) { const int R1 = (half * 4 + d) * 64 + n2; *(LAS unsigned*)(D + R1 * 256 + (((n1 >> 2) ^ (R1 & 15)) * 16) + (n1 & 3) * 4) = v[i][d]; } } }
        __syncthreads();
        f32x4 aR[4][4], aI[4][4];
#pragma unroll
        for (int a = 0; a < 4; ++a)
#pragma unroll
            for (int kb = 0; kb < 4; ++kb) { aR[a][kb] = (f32x4){0.f, 0.f, 0.f, 0.f}; aI[a][kb] = (f32x4){0.f, 0.f, 0.f, 0.f}; }
#pragma unroll 1
        for (int ks = 0; ks < 4; ++ks) { const int ch = ((ks * 4 + fqv) ^ frv) * 16;
            bf16x8 Y[4], X[4];
#pragma unroll
            for (int kb = 0; kb < 4; ++kb) Y[kb] = *(const LAS bf16x8*)(CM + (kb * 16 + frv) * 256 + ch);
#pragma unroll
            for (int a = 0; a < 4; ++a) X[a] = *(const LAS bf16x8*)(D + (w * 64 + a * 16 + frv) * 256 + ch);
#pragma unroll
            for (int a = 0; a < 4; ++a) { const bf16x8 Xs = rot_negre(X[a]);
#pragma unroll
                for (int kb = 0; kb < 4; ++kb) { aR[a][kb] = __builtin_amdgcn_mfma_f32_16x16x32_bf16(X[a], Y[kb], aR[a][kb], 0, 0, 0); aI[a][kb] = __builtin_amdgcn_mfma_f32_16x16x32_bf16(Xs, Y[kb], aI[a][kb], 0, 0, 0); } } }
        __syncthreads();
#pragma unroll
        for (int a = 0; a < 4; ++a)
#pragma unroll
            for (int kb = 0; kb < 4; ++kb) { const int k1 = kb * 16 + frv, R3 = k1 * 8 + w; float o[8];
#pragma unroll
                for (int v = 0; v < 4; ++v) { const int n2 = a * 16 + fqv * 4 + v; const float ang = (float)((n2 * k1) & 4095) * (1.0f / 4096.0f);
                    const float c = __builtin_amdgcn_cosf(ang), s = __builtin_amdgcn_sinf(ang), tr = aR[a][kb][v], ti = aI[a][kb][v];
                    o[2 * v] = tr * c + ti * s; o[2 * v + 1] = ti * c - tr * s; }
                u32x4 pk; pk.x = cvt_pk_bf16(o[0], o[1]); pk.y = cvt_pk_bf16(o[2], o[3]); pk.z = cvt_pk_bf16(o[4], o[5]); pk.w = cvt_pk_bf16(o[6], o[7]);
                *(LAS u32x4*)(D + R3 * 256 + (((a * 4 + fqv) ^ f3swz(R3)) * 16)) = pk; }
        __syncthreads();
        f32x4 c3[4][4], cI[4][4];
#pragma unroll
        for (int a = 0; a < 4; ++a)
#pragma unroll
            for (int kb = 0; kb < 4; ++kb) { c3[a][kb] = (f32x4){0.f, 0.f, 0.f, 0.f}; cI[a][kb] = (f32x4){0.f, 0.f, 0.f, 0.f}; }
#pragma unroll 1
        for (int ks = 0; ks < 4; ++ks) {
            bf16x8 Y[4], X[4];
#pragma unroll
            for (int kb = 0; kb < 4; ++kb) Y[kb] = *(const LAS bf16x8*)(CM + (kb * 16 + frv) * 256 + (((ks * 4 + fqv) ^ frv) * 16));
#pragma unroll
            for (int jj = 0; jj < 4; ++jj) { const int R3 = (w * 4 + jj) * 16 + frv; X[jj] = *(const LAS bf16x8*)(D + R3 * 256 + (((ks * 4 + fqv) ^ f3swz(R3)) * 16)); }
#pragma unroll
            for (int jj = 0; jj < 4; ++jj) {
#pragma unroll
                for (int kb = 0; kb < 4; ++kb) c3[jj][kb] = __builtin_amdgcn_mfma_f32_16x16x32_bf16(X[jj], Y[kb], c3[jj][kb], 0, 0, 0);
                if (slab == 0) { const bf16x8 Xs = rot_negre(X[jj]);
#pragma unroll
                    for (int kb = 0; kb < 4; ++kb) cI[jj][kb] = __builtin_amdgcn_mfma_f32_16x16x32_bf16(Xs, Y[kb], cI[jj][kb], 0, 0, 0); } } }
        __syncthreads();
#pragma unroll
        for (int jj = 0; jj < 4; ++jj)
#pragma unroll
            for (int kb = 0; kb < 4; ++kb) { const int k1 = 2 * (w * 4 + jj) + (fqv >> 1), k2 = kb * 16 + frv, k = k1 + 64 * k2;
                u32x2 pk; pk.x = cvt_pk_bf16(c3[jj][kb][0], c3[jj][kb][1]); pk.y = cvt_pk_bf16(c3[jj][kb][2], c3[jj][kb][3]);
                *(LAS u32x2*)(D + (k + k2) * 16 + (fqv & 1) * 8) = pk;
                if (slab == 0 && (fqv & 1) == 0) *(LAS float*)(D + 98304 + k * 4) = cI[jj][kb][0]; }
        __syncthreads();
#pragma unroll 4
        for (int i = 0; i < 16; ++i) { const int q = tidv + NTHREADS * i, k = q >> 1, half = q & 1, km = (4096 - k) & 4095;
            const u32x4 a = *(const LAS u32x4*)(D + (k + (k >> 6)) * 16), bm = *(const LAS u32x4*)(D + (km + (km >> 6)) * 16);
            const u32x4 gt = *(const u32x4*)(Gs + k * 16 + half * 8);
            const u32x4 src = half ? bm : a; float vals[8];
#pragma unroll
            for (int d = 0; d < 4; ++d) { vals[2 * d] = bf_lo(src[d]); vals[2 * d + 1] = bf_hi(src[d]); }
            if (slab == 0) { if (half == 0) vals[0] = 0.5f * (bf_lo(a[0]) + bf_lo(bm[0])); else vals[0] = 0.5f * (*(const LAS float*)(D + 98304 + k * 4) + *(const LAS float*)(D + 98304 + km * 4)); }
            u32x4 o;
#pragma unroll
            for (int d = 0; d < 4; ++d) o[d] = cvt_pk_bf16(vals[2 * d] * bf_lo(gt[d]), vals[2 * d + 1] * bf_hi(gt[d]));
            *(u32x4*)(Ys + k * 16 + half * 8) = o; }
        __syncthreads();
    }
}

__device__ __forceinline__ int vswz(int row) { return (row & 15) ^ ((row >> 5) & 3); }
__device__ __forceinline__ void p5_sgu(Frame& F) {
    LAS unsigned char* VT = F.lds; LAS unsigned char* WS = F.lds + 65536;
    const int tid = F.tid, lane = F.lane, w = F.wave, fr = lane & 15, fq = lane >> 4;
    for (int item = F.bx; item < 2048; item += F.G) {
        int lanev = lane; asm volatile("" : "+v"(lanev));
        const int frv = lanev & 15, fqv = lanev >> 4, tidv = w * 64 + lanev;
        const int g = item & 7, n = (item >> 3) & 31, b = item >> 8, row0 = b * 4096 + n * 128, col0 = g * 256;
        u32x4 uu[8], zz[8];
#pragma unroll
        for (int jp = 0; jp < 8; ++jp) { const size_t off = (size_t)(row0 + jp * 16 + frv) * EI + col0 + w * 32 + fqv * 8; uu[jp] = *(const u32x4*)(F.BA + off); zz[jp] = *(const u32x4*)(F.BC + off); }
#pragma unroll
        for (int i = 0; i < 4; ++i) { const int idx = tidv + NTHREADS * i, p = idx >> 4, qc = idx & 15; const float* src = F.wsp + ((size_t)g * 128 + p) * 128 + qc * 8;
            const f32x4 a0 = *(const f32x4*)src, a1 = *(const f32x4*)(src + 4);
            *(LAS u32x4*)(WS + p * 256 + ((qc ^ (p & 15)) * 16)) = pack8(a0, a1); }
        { const int c8 = tidv & 31; float gam[8], bet[8];
            { const f32x4 g0 = *(const f32x4*)(F.lng + col0 + c8 * 8), g1 = *(const f32x4*)(F.lng + col0 + c8 * 8 + 4), b0 = *(const f32x4*)(F.lnb + col0 + c8 * 8), b1 = *(const f32x4*)(F.lnb + col0 + c8 * 8 + 4);
#pragma unroll
                for (int i = 0; i < 4; ++i) { gam[i] = g0[i]; gam[4 + i] = g1[i]; bet[i] = b0[i]; bet[4 + i] = b1[i]; } }
#pragma unroll
            for (int j = 0; j < 4; ++j) { const int q = 2 * ((tidv >> 5) + 16 * j), r0 = row0 + q;
                const u32x4 va = *(const u32x4*)(F.BB + (size_t)r0 * EI + col0 + c8 * 8), vb = *(const u32x4*)(F.BB + (size_t)(r0 + 1) * EI + col0 + c8 * 8);
                const float mu0 = F.vsum[r0] * (1.0f / EI), mu1 = F.vsum[r0 + 1] * (1.0f / EI);
                const float rs0 = __builtin_amdgcn_rsqf(fmaxf(F.vsq[r0] * (1.0f / EI) - mu0 * mu0, 0.f) + EPS), rs1 = __builtin_amdgcn_rsqf(fmaxf(F.vsq[r0 + 1] * (1.0f / EI) - mu1 * mu1, 0.f) + EPS);
#pragma unroll
                for (int i = 0; i < 8; ++i) { const float x0 = (i & 1) ? bf_hi(va[i >> 1]) : bf_lo(va[i >> 1]), x1 = (i & 1) ? bf_hi(vb[i >> 1]) : bf_lo(vb[i >> 1]);
                    const float y0 = (x0 - mu0) * rs0 * gam[i] + bet[i], y1 = (x1 - mu1) * rs1 * gam[i] + bet[i];
                    const int c = c8 * 8 + i, cl = c & 31, row = (c & ~31) + 16 * ((cl >> 2) & 1) + 4 * (cl >> 3) + (cl & 3);
                    *(LAS unsigned*)(VT + row * 256 + (((q >> 3) ^ vswz(row)) * 16) + (q & 7) * 2) = cvt_pk_bf16(y0, y1); } } }
        __syncthreads();
        f32x4 acc[2][8];
#pragma unroll
        for (int nn = 0; nn < 2; ++nn)
#pragma unroll
            for (int jp = 0; jp < 8; ++jp) acc[nn][jp] = (f32x4){0.f, 0.f, 0.f, 0.f};
#pragma unroll
        for (int ks = 0; ks < 4; ++ks) { bf16x8 X[2], Y[8];
#pragma unroll
            for (int nn = 0; nn < 2; ++nn) { const int row = w * 32 + nn * 16 + frv; X[nn] = *(const LAS bf16x8*)(VT + row * 256 + (((ks * 4 + fqv) ^ vswz(row)) * 16)); }
#pragma unroll
            for (int jp = 0; jp < 8; ++jp) Y[jp] = *(const LAS bf16x8*)(WS + (jp * 16 + frv) * 256 + (((ks * 4 + fqv) ^ frv) * 16));
#pragma unroll
            for (int nn = 0; nn < 2; ++nn)
#pragma unroll
                for (int jp = 0; jp < 8; ++jp) acc[nn][jp] = __builtin_amdgcn_mfma_f32_16x16x32_bf16(X[nn], Y[jp], acc[nn][jp], 0, 0, 0); }
#pragma unroll
        for (int jp = 0; jp < 8; ++jp) { const int p = jp * 16 + frv; const float bs = F.bsp[g * 128 + p]; u32x4 o;
#pragma unroll
            for (int d = 0; d < 4; ++d) { const f32x4 a = acc[d >> 1][jp]; const float m0 = a[(d & 1) * 2] + bs, m1 = a[(d & 1) * 2 + 1] + bs;
                o[d] = cvt_pk_bf16(bf_lo(uu[jp][d]) * m0 * bf_lo(zz[jp][d]), bf_hi(uu[jp][d]) * m1 * bf_hi(zz[jp][d])); }
            *(u32x4*)(F.BA + (size_t)(row0 + p) * EI + col0 + w * 32 + fqv * 8) = o; }
        __syncthreads();
    }
}

__device__ __forceinline__ void p7_final(Frame& F) {
    const int gw = F.bx * NWAVES + F.wave, NGW = F.G * NWAVES;
    for (int m = gw; m < MROWS; m += NGW) {
        f32x4* xr = (f32x4*)(F.out + (size_t)m * DM) + F.lane; const f32x4* gr = (const f32x4*)F.nf + F.lane;
        const float rstd = __builtin_amdgcn_rsqf(F.ss2[m] * (1.0f / DM) + EPS);
#pragma unroll
        for (int j = 0; j < 4; ++j) { const f32x4 v = xr[64 * j], gg = gr[64 * j]; xr[64 * j] = v * gg * rstd; }
    }
}

__global__ void __launch_bounds__(NTHREADS, 2) fwd_megakernel(Args args) {
    extern __shared__ __attribute__((aligned(16))) unsigned char lds_raw[];
    cg::grid_group grid = cg::this_grid();
    Frame F;
    F.lds = (LAS unsigned char*)lds_raw; F.tid = threadIdx.x; F.lane = F.tid & 63; F.wave = __builtin_amdgcn_readfirstlane(F.tid >> 6); F.G = gridDim.x; F.bx = blockIdx.x;
    F.x = args.in[0]; F.n0 = args.in[1]; F.win0 = args.in[2]; F.wout0 = args.in[3]; F.n1 = args.in[4]; F.win1 = args.in[5]; F.lng = args.in[6]; F.lnb = args.in[7];
    F.wsp = args.in[8]; F.bsp = args.in[9]; F.wout1 = args.in[10]; F.nf = args.in[11]; F.out = args.out;
    unsigned char* ws = args.ws;
    F.ss1 = (float*)(ws + WS_SS1); F.vsum = (float*)(ws + WS_VSUM); F.vsq = (float*)(ws + WS_VSQ); F.ss2 = (float*)(ws + WS_SS2);
    F.W0t = (bf16_t*)(ws + WS_W0T); F.Wo0t = (bf16_t*)(ws + WS_WO0T); F.W1t = (bf16_t*)(ws + WS_W1T); F.Wo1t = (bf16_t*)(ws + WS_WO1T);
    F.HB = (bf16_t*)(ws + WS_HB); F.BA = (bf16_t*)(ws + WS_BUFA); F.BB = (bf16_t*)(ws + WS_BUFB); F.BC = (bf16_t*)(ws + WS_BUFC);

#ifndef PHM
#define PHM 255
#endif
    if (PHM & 1) p0_prep(F);
    grid.sync();
    if (PHM & 2) { pg8::Gemm g{F.HB, F.W0t, MROWS, 4096, DM}; pg8::StaticOrder S; S.init(MROWS, 4096, F.G, F.bx); Epi1 E{F.BA, F.BB};
      pg8::gemm_phase<Epi1, false>(F.lds, g, S, E); }
    grid.sync();
    if (PHM & 4) p2_fft(F);
    grid.sync();
    if (PHM & 8) { pg8::Gemm g{F.BC, F.Wo0t, MROWS, DM, EI}; pg8::StaticOrder S; S.init(MROWS, DM, F.G, F.bx); EpiRes<true> E{F.x, F.out, F.HB, F.ss1};
      pg8::gemm_phase<EpiRes<true>, true>(F.lds, g, S, E); }
    grid.sync();
    if (PHM & 16) { pg8::Gemm g{F.HB, F.W1t, MROWS, 6144, DM}; pg8::StaticOrder S; S.init(MROWS, 6144, F.G, F.bx); Epi3 E{F.ss1, F.BA, F.vsum, F.vsq};
      pg8::gemm_phase<Epi3, false>(F.lds, g, S, E); }
    grid.sync();
    if (PHM & 32) p5_sgu(F);
    grid.sync();
    if (PHM & 64) { pg8::Gemm g{F.BA, F.Wo1t, MROWS, DM, EI}; pg8::StaticOrder S; S.init(MROWS, DM, F.G, F.bx); EpiRes<false> E{F.out, F.out, nullptr, F.ss2};
      pg8::gemm_phase<EpiRes<false>, false>(F.lds, g, S, E); }
    grid.sync();
    if (PHM & 128) p7_final(F);
}

extern "C" void kernel_launch(void* const* d_in, const int* in_sizes, int n_in, void* d_out, int out_size, void* d_ws, size_t ws_size, hipStream_t stream) {
    static int grid = 0;
    if (!grid) {
        if (n_in != 12 || in_sizes[0] != MROWS * DM || out_size != MROWS * DM || ws_size < WS_END) {
            fprintf(stderr, "kernel_launch: unexpected problem (n_in %d, in0 %d, out %d, ws %zu); nothing launched\n", n_in, in_sizes[0], out_size, ws_size); grid = -1; return; }
        int dev = 0, cus = 0, per_cu = 0;
        if (hipGetDevice(&dev) != hipSuccess || hipDeviceGetAttribute(&cus, hipDeviceAttributeMultiprocessorCount, dev) != hipSuccess) { grid = -1; return; }
        if (hipFuncSetAttribute((const void*)fwd_megakernel, hipFuncAttributeMaxDynamicSharedMemorySize, LDS_BYTES) != hipSuccess) { fprintf(stderr, "kernel_launch: hipFuncSetAttribute failed\n"); grid = -1; return; }
        if (hipOccupancyMaxActiveBlocksPerMultiprocessor(&per_cu, (const void*)fwd_megakernel, NTHREADS, LDS_BYTES) != hipSuccess || per_cu < 1) per_cu = 1;
        grid = cus * per_cu;
    }
    if (grid < 0) return;
    Args a{};
    for (int i = 0; i < 12; ++i) a.in[i] = (const float*)d_in[i];
    a.out = (float*)d_out; a.ws = (unsigned char*)d_ws;
    void* kargs[] = {&a};
    hipError_t e = hipLaunchCooperativeKernel((const void*)fwd_megakernel, dim3(grid), dim3(NTHREADS), kargs, LDS_BYTES, stream);
    if (e != hipSuccess) fprintf(stderr, "kernel_launch: cooperative launch failed: %s (grid %d)\n", hipGetErrorString(e), grid);
}
```

```cpp
#include <hip/hip_runtime.h>
#include <hip/hip_cooperative_groups.h>
#include <cstdio>
#include <cstdint>
namespace cg = cooperative_groups;

#define LAS __attribute__((address_space(3)))
typedef unsigned short bf16_t;
typedef short bf16x8 __attribute__((ext_vector_type(8)));
typedef float f32x4 __attribute__((ext_vector_type(4)));
typedef float f32x2 __attribute__((ext_vector_type(2)));
typedef unsigned u32x4 __attribute__((ext_vector_type(4)));
typedef unsigned u32x2 __attribute__((ext_vector_type(2)));

constexpr int MROWS = 32768, DM = 1024, EI = 2048, SEQ = 4096;
constexpr float EPS = 1e-6f;
constexpr int NTHREADS = 512, NWAVES = 8;
constexpr int LDS_BYTES = 148480;
constexpr size_t MiB = 1u << 20;
constexpr size_t WS_SS1 = 0, WS_VSUM = 128 * 1024, WS_VSQ = 256 * 1024, WS_SS2 = 384 * 1024, WS_BAR = 512 * 1024;
constexpr int MISC_OFF = 147456;
constexpr size_t WS_W0T = 1 * MiB, WS_WO0T = 9 * MiB, WS_W1T = 13 * MiB, WS_WO1T = 25 * MiB;
constexpr size_t WS_HB = 32 * MiB, WS_BUFA = 96 * MiB, WS_BUFB = 224 * MiB, WS_BUFC = 352 * MiB, WS_END = 480 * MiB;

__device__ __forceinline__ unsigned cvt_pk_bf16(float lo, float hi) { unsigned r; asm volatile("v_cvt_pk_bf16_f32 %0, %1, %2" : "=v"(r) : "v"(lo), "v"(hi)); return r; }
__device__ __forceinline__ float bf_lo(unsigned u) { return __uint_as_float(u << 16); }
__device__ __forceinline__ float bf_hi(unsigned u) { return __uint_as_float(u & 0xffff0000u); }
__device__ __forceinline__ float silu_f(float x) { return x * __builtin_amdgcn_rcpf(1.0f + __builtin_amdgcn_exp2f(-1.4426950409f * x)); }
__device__ __forceinline__ float gelu_f(float x) { const float t = x * (1.0f + 0.044715f * x * x); return x * __builtin_amdgcn_rcpf(1.0f + __builtin_amdgcn_exp2f(-2.302208198f * t)); }
__device__ __forceinline__ float wave_sum(float v) {
#pragma unroll
    for (int o = 1; o < 64; o <<= 1) v += __shfl_xor(v, o);
    return v;
}
__host__ __device__ __forceinline__ int chan_of_pos(int p) { const int s = p >> 4, e = p & 15; if (e < 8) return 8 * s + e; const int j = 8 * s + (e - 8); return j == 0 ? 128 : 256 - j; }
__host__ __device__ __forceinline__ int pos_of_chan(int ch) { if (ch < 128) return 16 * (ch >> 3) + (ch & 7); if (ch == 128) return 8; const int j = 256 - ch; return 16 * (j >> 3) + 8 + (j & 7); }

namespace pg8 {
constexpr int BM = 256, BK = 64, HALF = 128, HTB = HALF * BK * 2, STAGE_BYTES = 8 * HTB, NXCD = 8, WGM = 8;
__host__ __device__ __forceinline__ int lds_byte(int r, int c) { const int st = (r >> 4) * 2 + (c >> 5), rr = r & 15, cc = c & 31, ob = rr * 64 + cc * 2; return st * 1024 + (ob ^ (((ob >> 9) & 1) << 5)); }
__host__ __device__ __forceinline__ void stage_rc(int b, int& R, int& C) { const int st = b / 1024, sb = b % 1024, swz = sb ^ (((sb >> 9) & 1) << 5); R = (st >> 1) * 16 + swz / 64; C = (st & 1) * 32 + (swz % 64) / 2; }
__host__ __device__ __forceinline__ int perm32(int rho) { const int n = rho >> 4, i = rho & 15; return 8 * (i >> 2) + 4 * n + (i & 3); }
struct Unit { int pm, pn; };
struct Gemm { const bf16_t* A; const bf16_t* Bt; int M, N, K; };
struct StaticOrder {
    int nM, nN, nwg, G, c;
    __host__ __device__ void init(int M, int N, int G_, int c_) { nM = M / BM; nN = N / BM; nwg = nM * nN; G = G_; c = c_; }
    __host__ __device__ bool next(int i, Unit& u) const {
        const long L = (long)i * G + c; if (L >= nwg) return false;
        int wgid = (int)L; { const int q = nwg / NXCD, r = nwg % NXCD, xcd = wgid % NXCD, off = wgid / NXCD; wgid = (xcd < r ? xcd * (q + 1) : r * (q + 1) + (xcd - r) * q) + off; }
        const int nig = WGM * nN, gid = wgid / nig, fm = gid * WGM, gsz = (nM - fm) < WGM ? (nM - fm) : WGM;
        u.pm = fm + ((wgid % nig) % gsz); u.pn = (wgid % nig) / gsz; return true;
    }
};
template <class Epi, bool ABLK>
__device__ __forceinline__ void gemm_phase(LAS unsigned char* lds, const Gemm g, const StaticOrder& S, const Epi& E) {
    const int tid = threadIdx.x, wid = __builtin_amdgcn_readfirstlane(tid >> 6), lane = tid & 63, wr = wid >> 2, wc = wid & 3, fr = lane & 15, fq = lane >> 4;
    const int K = g.K, nt = K / BK;
    unsigned voffA[2], voffB[2];
#pragma unroll
    for (int i = 0; i < 2; ++i) { int R, C; stage_rc(tid * 16 + i * 8192, R, C); const int Rb = (R & ~31) + perm32(R & 31);
        voffA[i] = ABLK ? (unsigned)((C >> 4) * 65536 + R * 16 + (C & 15)) * 2u : (unsigned)(R * K + C) * 2u; voffB[i] = (unsigned)(Rb * K + C) * 2u; }
    const size_t kstepB = (size_t)(BK * 2), hstepB = (size_t)HALF * K * 2, tstepB = 2 * hstepB;
    const size_t kstepA = ABLK ? (size_t)4 * 65536 * 2 : kstepB, hstepA = ABLK ? (size_t)HALF * 16 * 2 : hstepB;
#define PG8_ABASE(pm) ((const char*)g.A + (ABLK ? ((size_t)((pm) >> 4) * 4096 * 2048 + (size_t)((pm) & 15) * 256 * 16) * 2 : (size_t)(pm) * tstepB))
    const unsigned ldsw = (unsigned)wid * 1024u;
    const int aoff = lds_byte(wr * 64 + fr, fq * 8), boff = lds_byte(wc * 32 + fr, fq * 8);
#define PG8_SA(b, h) (((b) * 2 + (h)) * HTB)
#define PG8_SB(b, h) ((4 + (b) * 2 + (h)) * HTB)
#define PG8_STAGE(bufoff, gbase, voff) do { _Pragma("unroll") for (int _i = 0; _i < 2; ++_i) \
        __builtin_amdgcn_global_load_lds((const unsigned*)((const char*)(gbase) + (voff)[_i]), (LAS unsigned*)(lds + (bufoff) + ldsw + _i * 8192), 16, 0, 0); } while (0)
#define PG8_LDA(dst, b, h) do { _Pragma("unroll") for (int m = 0; m < 4; ++m) _Pragma("unroll") for (int k = 0; k < 2; ++k) dst[m][k] = *(const LAS bf16x8*)(lds + PG8_SA(b, h) + aoff + m * 2048 + k * 1024); } while (0)
#define PG8_LDB(dst, b, h) do { _Pragma("unroll") for (int n = 0; n < 2; ++n) _Pragma("unroll") for (int k = 0; k < 2; ++k) dst[n][k] = *(const LAS bf16x8*)(lds + PG8_SB(b, h) + boff + n * 2048 + k * 1024); } while (0)
#define PG8_MMA(ai, bj, At, Bt) do { __builtin_amdgcn_s_setprio(1); _Pragma("unroll") for (int m = 0; m < 4; ++m) _Pragma("unroll") for (int n = 0; n < 2; ++n) _Pragma("unroll") for (int k = 0; k < 2; ++k) \
        acc[ai][bj][m][n] = __builtin_amdgcn_mfma_f32_16x16x32_bf16(Bt[n][k], At[m][k], acc[ai][bj][m][n], 0, 0, 0); __builtin_amdgcn_s_setprio(0); } while (0)
#define PG8_WAIT_V(n) asm volatile("s_waitcnt vmcnt(" #n ")" ::: "memory")
#define PG8_WAIT_L(n) asm volatile("s_waitcnt lgkmcnt(" #n ")" ::: "memory")
#define PG8_BAR __builtin_amdgcn_s_barrier()
#define PG8_SCHED __builtin_amdgcn_sched_barrier(0)
    Unit cur, nxt; int ui = 0;
    if (!S.next(0, cur)) return;
    f32x4 acc[2][2][4][2];
#pragma unroll
    for (int a = 0; a < 2; ++a)
#pragma unroll
        for (int b = 0; b < 2; ++b)
#pragma unroll
            for (int m = 0; m < 4; ++m)
#pragma unroll
                for (int n = 0; n < 2; ++n) acc[a][b][m][n] = (f32x4){0.f, 0.f, 0.f, 0.f};
    bf16x8 At[4][2], B0[2][2], B1[2][2];
    const char* cA = PG8_ABASE(cur.pm); const char* cB = (const char*)g.Bt + (size_t)cur.pn * tstepB;
    PG8_STAGE(PG8_SB(0, 0), cB, voffB); PG8_STAGE(PG8_SB(0, 1), cB + hstepB, voffB); PG8_STAGE(PG8_SA(0, 0), cA, voffA); PG8_STAGE(PG8_SA(0, 1), cA + hstepA, voffA);
    if (wr == 1) PG8_BAR;
    PG8_WAIT_V(2); PG8_BAR;
    PG8_STAGE(PG8_SB(1, 0), cB + kstepB, voffB); PG8_STAGE(PG8_SA(1, 0), cA + kstepA, voffA); PG8_STAGE(PG8_SB(1, 1), cB + hstepB + kstepB, voffB);
    PG8_WAIT_V(6); PG8_BAR;
    for (;;) {
        const bool has_next = S.next(ui + 1, nxt);
        const char* nA = has_next ? PG8_ABASE(nxt.pm) : cA; const char* nB = has_next ? (const char*)g.Bt + (size_t)nxt.pn * tstepB : cB;
        for (int t = 0; t < nt; t += 2) {
            const bool last = (t == nt - 2);
            const char* a1 = cA + (size_t)(t + 1) * kstepA;
            const char* a2 = last ? nA : cA + (size_t)(t + 2) * kstepA; const char* b2 = last ? nB : cB + (size_t)(t + 2) * kstepB;
            const char* a3 = a2 + kstepA; const char* b3 = b2 + kstepB;
            PG8_LDB(B0, 0, 0); PG8_LDB(B1, 0, 1); PG8_SCHED; PG8_LDA(At, 0, 0); PG8_STAGE(PG8_SA(1, 1), a1 + hstepA, voffA);
            PG8_WAIT_V(8); PG8_WAIT_L(0); PG8_BAR; PG8_MMA(0, 0, At, B0); PG8_MMA(0, 1, At, B1); PG8_BAR; PG8_SCHED;
            PG8_LDA(At, 0, 1); PG8_STAGE(PG8_SB(0, 0), b2, voffB); PG8_STAGE(PG8_SB(0, 1), b2 + hstepB, voffB); PG8_STAGE(PG8_SA(0, 0), a2, voffA);
            PG8_WAIT_V(8); PG8_WAIT_L(0); PG8_BAR; PG8_MMA(1, 0, At, B0); PG8_MMA(1, 1, At, B1); PG8_BAR; PG8_SCHED;
            PG8_LDB(B0, 1, 0); PG8_LDB(B1, 1, 1); PG8_SCHED; PG8_LDA(At, 1, 0); PG8_STAGE(PG8_SA(0, 1), a2 + hstepA, voffA);
            PG8_WAIT_V(8); PG8_WAIT_L(0); PG8_BAR; PG8_MMA(0, 0, At, B0); PG8_MMA(0, 1, At, B1); PG8_BAR; PG8_SCHED;
            PG8_LDA(At, 1, 1); PG8_STAGE(PG8_SB(1, 0), b3, voffB); PG8_STAGE(PG8_SB(1, 1), b3 + hstepB, voffB); PG8_STAGE(PG8_SA(1, 0), a3, voffA);
            PG8_WAIT_V(8); PG8_WAIT_L(0); PG8_BAR; PG8_MMA(1, 0, At, B0); PG8_MMA(1, 1, At, B1); PG8_BAR; PG8_SCHED;
        }
        if (wr == 0) PG8_BAR;
        E(acc, cur, wr, wc, fr, fq);
        if (!has_next) break;
#pragma unroll
        for (int a = 0; a < 2; ++a)
#pragma unroll
            for (int b = 0; b < 2; ++b)
#pragma unroll
                for (int m = 0; m < 4; ++m)
#pragma unroll
                    for (int n = 0; n < 2; ++n) acc[a][b][m][n] = (f32x4){0.f, 0.f, 0.f, 0.f};
        cur = nxt; cA = nA; cB = nB; ++ui;
        if (wr == 1) PG8_BAR;
    }
    PG8_WAIT_V(0);
    PG8_BAR;
#undef PG8_ABASE
#undef PG8_SA
#undef PG8_SB
#undef PG8_STAGE
#undef PG8_LDA
#undef PG8_LDB
#undef PG8_MMA
#undef PG8_WAIT_V
#undef PG8_WAIT_L
#undef PG8_BAR
#undef PG8_SCHED
}
}

__device__ __forceinline__ u32x4 pack8(const f32x4 v0, const f32x4 v1) { u32x4 w; w.x = cvt_pk_bf16(v0[0], v0[1]); w.y = cvt_pk_bf16(v0[2], v0[3]); w.z = cvt_pk_bf16(v1[0], v1[1]); w.w = cvt_pk_bf16(v1[2], v1[3]); return w; }

struct Epi1 {
    bf16_t* Z; bf16_t* SZ;
    __device__ __forceinline__ void operator()(const f32x4 (&acc)[2][2][4][2], const pg8::Unit& u, int wr, int wc, int fr, int fq) const {
        const int b = u.pm >> 4, t0 = (u.pm & 15) * 256 + wr * 64 + fr; const bool gate = u.pn >= 8; const int g = u.pn & 7;
        bf16_t* base = (gate ? SZ : Z) + (size_t)(b * 8 + g) * (16 * 4096 * 16);
#pragma unroll
        for (int ai = 0; ai < 2; ++ai)
#pragma unroll
            for (int m = 0; m < 4; ++m) { const int t = t0 + ai * 128 + m * 16;
#pragma unroll
                for (int bj = 0; bj < 2; ++bj) { const int cgp = bj * 128 + wc * 32 + fq * 8, s = cgp >> 4, e0 = cgp & 8;
                    f32x4 v0 = acc[ai][bj][m][0], v1 = acc[ai][bj][m][1];
                    if (gate) {
#pragma unroll
                        for (int j = 0; j < 4; ++j) { v0[j] = silu_f(v0[j]); v1[j] = silu_f(v1[j]); } }
                    *(u32x4*)(base + ((size_t)s * 4096 + t) * 16 + e0) = pack8(v0, v1); } }
    }
};
template <bool WB> struct EpiRes {
    const float* XIN; float* XO; bf16_t* XB; float* SS;
    __device__ __forceinline__ void operator()(const f32x4 (&acc)[2][2][4][2], const pg8::Unit& u, int wr, int wc, int fr, int fq) const {
        const int row0 = u.pm * 256 + wr * 64 + fr, col0 = u.pn * 256 + wc * 32 + fq * 8;
#pragma unroll
        for (int ai = 0; ai < 2; ++ai)
#pragma unroll
            for (int m = 0; m < 4; ++m) { const int row = row0 + ai * 128 + m * 16; float ss = 0.f;
#pragma unroll
                for (int bj = 0; bj < 2; ++bj) { const size_t off = (size_t)row * DM + col0 + bj * 128;
                    const f32x4 x0 = *(const f32x4*)(XIN + off), x1 = *(const f32x4*)(XIN + off + 4);
                    const f32x4 v0 = acc[ai][bj][m][0] + x0, v1 = acc[ai][bj][m][1] + x1;
                    *(f32x4*)(XO + off) = v0; *(f32x4*)(XO + off + 4) = v1;
                    if (WB) *(u32x4*)(XB + off) = pack8(v0, v1);
                    ss += (v0[0] * v0[0] + v0[1] * v0[1]) + (v0[2] * v0[2] + v0[3] * v0[3]) + (v1[0] * v1[0] + v1[1] * v1[1]) + (v1[2] * v1[2] + v1[3] * v1[3]); }
                ss += __shfl_xor(ss, 16); ss += __shfl_xor(ss, 32);
                if (fq == 0) atomicAdd(SS + row, ss); }
    }
};
struct Epi3 {
    const float* SS1; bf16_t* U; float* VSUM; float* VSQ;
    __device__ __forceinline__ void operator()(const f32x4 (&acc)[2][2][4][2], const pg8::Unit& u, int wr, int wc, int fr, int fq) const {
        const int row0 = u.pm * 256 + wr * 64 + fr, which = u.pn >> 3, col0 = (u.pn & 7) * 256 + wc * 32 + fq * 8;
        bf16_t* dst = U + (size_t)which * ((WS_BUFB - WS_BUFA) / 2);
#pragma unroll
        for (int ai = 0; ai < 2; ++ai)
#pragma unroll
            for (int m = 0; m < 4; ++m) { const int row = row0 + ai * 128 + m * 16;
                const float rs = __builtin_amdgcn_rsqf(SS1[row] * (1.0f / DM) + EPS); float s1 = 0.f, s2 = 0.f;
#pragma unroll
                for (int bj = 0; bj < 2; ++bj) { f32x4 v0 = acc[ai][bj][m][0] * rs, v1 = acc[ai][bj][m][1] * rs;
                    if (which == 2) {
#pragma unroll
                        for (int j = 0; j < 4; ++j) { v0[j] = silu_f(v0[j]); v1[j] = silu_f(v1[j]); } }
                    else {
#pragma unroll
                        for (int j = 0; j < 4; ++j) { v0[j] = gelu_f(v0[j]); v1[j] = gelu_f(v1[j]); } }
                    if (which == 1) { s1 += (v0[0] + v0[1]) + (v0[2] + v0[3]) + (v1[0] + v1[1]) + (v1[2] + v1[3]);
                        s2 += (v0[0] * v0[0] + v0[1] * v0[1]) + (v0[2] * v0[2] + v0[3] * v0[3]) + (v1[0] * v1[0] + v1[1] * v1[1]) + (v1[2] * v1[2] + v1[3] * v1[3]); }
                    *(u32x4*)(dst + (size_t)row * EI + col0 + bj * 128) = pack8(v0, v1); }
                if (which == 1) { s1 += __shfl_xor(s1, 16); s1 += __shfl_xor(s1, 32); s2 += __shfl_xor(s2, 16); s2 += __shfl_xor(s2, 32);
                    if (fq == 0) { atomicAdd(VSUM + row, s1); atomicAdd(VSQ + row, s2); } } }
    }
};


#define XB_TMO      128
#define XB_XCNT(j)  (256  + 64 * (j))
#define XB_XSUB(j)  (1280 + 64 * (j))
#define XB_XGEN(j)  (2304 + 64 * (j))
#define XB_TOP      3328
#define XB_TOPGEN   3392
#define XCD_BAR_WORDS 3456
#define XB_SPIN_CAP (1u << 18)
__device__ __forceinline__ unsigned xb_ld(unsigned* p)              { return __hip_atomic_load(p, __ATOMIC_RELAXED, __HIP_MEMORY_SCOPE_AGENT); }
__device__ __forceinline__ unsigned xb_add(unsigned* p, unsigned v) { return __hip_atomic_fetch_add(p, v, __ATOMIC_RELAXED, __HIP_MEMORY_SCOPE_AGENT); }
__device__ __forceinline__ unsigned xb_xcc_id() { return (unsigned)__builtin_amdgcn_s_getreg((3 << 11) | 20) & 0xFu; }
#define XB_SPIN(cond, bar) do { unsigned _sp = 0; while (cond) { __builtin_amdgcn_s_sleep(1); \
    if ((++_sp & 255u) == 0u) { if (xb_ld(&(bar)[XB_TMO])) break; if (_sp > XB_SPIN_CAP) { atomicAdd(&(bar)[XB_TMO], 1u); break; } } } } while (0)
struct XcdBarrier { unsigned* bar; unsigned x; volatile LAS unsigned* st; };
__device__ __forceinline__ XcdBarrier xcd_barrier_post(unsigned* bar, volatile LAS unsigned* st) {
    XcdBarrier b; b.bar = bar; b.x = xb_xcc_id(); b.st = st;
    if (threadIdx.x == 0) (void)xb_add(&bar[XB_XCNT(b.x)], 1u);
    return b;
}
__device__ __forceinline__ void xcd_barrier_complete(unsigned* bar, unsigned x, unsigned& nloc, unsigned& nx) {
    const unsigned G = gridDim.x * gridDim.y * gridDim.z;
    unsigned sum, cnt, mine, sp = 0u;
    for (;;) {
        sum = 0u; cnt = 0u; mine = 0u;
#pragma unroll
        for (unsigned j = 0; j < 16; ++j) { const unsigned c = xb_ld(&bar[XB_XCNT(j)]); sum += c; cnt += (c > 0u) ? 1u : 0u; mine = (j == x) ? c : mine; }
        if (sum == G) break;
        __builtin_amdgcn_s_sleep(1);
        if ((++sp & 255u) == 0u) { if (xb_ld(&bar[XB_TMO])) break; if (sp > XB_SPIN_CAP) { atomicAdd(&bar[XB_TMO], 1u); break; } }
    }
    nloc = mine > 0u ? mine : 1u; nx = cnt > 0u ? cnt : 1u;
}
__device__ __forceinline__ void xcd_barrier(const XcdBarrier& b) {
    asm volatile("s_waitcnt vmcnt(0)" ::: "memory");
    __syncthreads();
    if (threadIdx.x == 0) {
        unsigned* bar = b.bar;
        __builtin_amdgcn_s_waitcnt(0);
        unsigned nloc = b.st[0], nx = b.st[1];
        if (nloc == 0u) { xcd_barrier_complete(bar, b.x, nloc, nx); b.st[0] = nloc; b.st[1] = nx; }
        const unsigned old = xb_add(&bar[XB_XSUB(b.x)], 1u);
        const unsigned gen = old / nloc;
        if (old + 1u == (gen + 1u) * nloc) {
            __builtin_amdgcn_fence(__ATOMIC_RELEASE, "agent");
            asm volatile("s_waitcnt vmcnt(0)" ::: "memory");
            const unsigned og = xb_add(&bar[XB_TOP], 1u);
            const unsigned tg = og / nx;
            if (og + 1u == (tg + 1u) * nx) xb_add(&bar[XB_TOPGEN], 1u);
            else XB_SPIN(xb_ld(&bar[XB_TOPGEN]) == tg, bar);
            __builtin_amdgcn_fence(__ATOMIC_ACQUIRE, "agent");
            xb_add(&bar[XB_XGEN(b.x)], 1u);
            asm volatile("s_waitcnt vmcnt(0)" ::: "memory");
        } else {
            XB_SPIN(xb_ld(&bar[XB_XGEN(b.x)]) == gen, bar);
            __builtin_amdgcn_fence(__ATOMIC_ACQUIRE, "agent");
            asm volatile("s_waitcnt vmcnt(0)" ::: "memory");
        }
    }
    __syncthreads();
}

struct Args { const float* in[12]; float* out; unsigned char* ws; };
struct Frame {
    LAS unsigned char* lds; int tid, lane, wave, G, bx;
    const float *x, *n0, *win0, *wout0, *n1, *win1, *lng, *lnb, *wsp, *bsp, *wout1, *nf; float* out;
    float *ss1, *vsum, *vsq, *ss2;
    bf16_t *W0t, *Wo0t, *W1t, *Wo1t, *HB, *BA, *BB, *BC;
};

__device__ __forceinline__ void p0_transpose_item(const float* W, int N, bf16_t* WT, int Kd, LAS float* scr, int k0, int n0, int lane, int mode, const float* kscale) {
#pragma unroll 8
    for (int i = 0; i < 32; ++i) { const int kk = 2 * i + (lane >> 5), k = k0 + kk; const int sr = (mode == 2) ? ((k & ~255) + chan_of_pos(k & 255)) : k;
        float v = W[(size_t)sr * N + n0 + (lane & 31)]; if (mode == 3) v *= kscale[k]; scr[kk * 33 + (lane & 31)] = v; }
    asm volatile("s_waitcnt lgkmcnt(0)" ::: "memory");
    const int c = lane & 7;
#pragma unroll
    for (int j = 0; j < 4; ++j) { const int n = (lane >> 3) + 8 * j; const LAS float* s = scr + (8 * c) * 33 + n; const int ns = n0 + n;
        const int dr = (mode == 1) ? (2048 + (ns & 0x700) + pos_of_chan(ns & 255)) : ns;
        u32x4 o; o.x = cvt_pk_bf16(s[0 * 33], s[1 * 33]); o.y = cvt_pk_bf16(s[2 * 33], s[3 * 33]); o.z = cvt_pk_bf16(s[4 * 33], s[5 * 33]); o.w = cvt_pk_bf16(s[6 * 33], s[7 * 33]);
        *(u32x4*)(WT + (size_t)dr * Kd + k0 + 8 * c) = o; }
    asm volatile("s_waitcnt lgkmcnt(0)" ::: "memory");
}
__device__ __forceinline__ void p0_prep(Frame& F) {
    LAS float* scr = (LAS float*)(F.lds + F.wave * 16384);
    LAS float* costab = (LAS float*)(F.lds + 131072);
    if (F.tid < 256) costab[F.tid] = cospif((float)F.tid * (1.0f / 128.0f)) * (1.0f / 16.0f);
    __syncthreads();
    const int gw = F.bx * NWAVES + F.wave, NGW = F.G * NWAVES;
    for (int i = F.bx * NTHREADS + F.tid; i < 4 * MROWS + 4096; i += F.G * NTHREADS) F.ss1[i] = 0.f;
    constexpr int I_A = 16 * 64, I_B = 32 * 32, I_C = 16 * 192, I_D = 32 * 32;
    for (int it = gw; it < I_A + I_B + I_C + I_D; it += NGW) {
        int r = it;
        if (r < I_A) { const int kb = r >> 6, nb = r & 63; p0_transpose_item(F.win0, 4096, F.W0t, 1024, scr, kb * 64, 2048 + nb * 32, F.lane, 1, nullptr); continue; } r -= I_A;
        if (r < I_B) { const int kb = r >> 5, nb = r & 31; p0_transpose_item(F.wout0, 1024, F.Wo0t, 2048, scr, kb * 64, nb * 32, F.lane, 2, nullptr); continue; } r -= I_B;
        if (r < I_C) { const int kb = r / 192, nb = r % 192; p0_transpose_item(F.win1, 6144, F.W1t, 1024, scr, kb * 64, nb * 32, F.lane, 3, F.n1); continue; } r -= I_C;
        { const int kb = r >> 5, nb = r & 31; p0_transpose_item(F.wout1, 1024, F.Wo1t, 2048, scr, kb * 64, nb * 32, F.lane, 0, nullptr); }
    }
    for (int task = gw; task < 4096; task += NGW) {
        const int kb = task >> 5, g = (task >> 2) & 7, pc = task & 3, P = pc * 64 + F.lane;
        const int jeff = (P == 1) ? 128 : (P >> 1), phase = (P >= 3 && (P & 1)) ? 64 : 0;
        const float* wp = F.win0 + (size_t)(kb * 8) * 4096 + g * 256;
#pragma unroll
        for (int i = 0; i < 8; ++i) *(LAS f32x4*)(scr + i * 256 + F.lane * 4) = *(const f32x4*)(wp + (size_t)i * 4096 + F.lane * 4);
        asm volatile("s_waitcnt vmcnt(0) lgkmcnt(0)" ::: "memory");
        float a[8];
#pragma unroll
        for (int i = 0; i < 8; ++i) a[i] = 0.f;
        for (int c = 0; c < 256; c += 4) {
            float t[4];
#pragma unroll
            for (int j = 0; j < 4; ++j) t[j] = costab[(jeff * (c + j) + phase) & 255];
#pragma unroll
            for (int i = 0; i < 8; ++i) { const f32x4 w = *(const LAS f32x4*)(scr + i * 256 + c); a[i] += w[0] * t[0]; a[i] += w[1] * t[1]; a[i] += w[2] * t[2]; a[i] += w[3] * t[3]; }
        }
        u32x4 o; o.x = cvt_pk_bf16(a[0], a[1]); o.y = cvt_pk_bf16(a[2], a[3]); o.z = cvt_pk_bf16(a[4], a[5]); o.w = cvt_pk_bf16(a[6], a[7]);
        *(u32x4*)(F.W0t + (size_t)(g * 256 + P) * 1024 + kb * 8) = o;
        asm volatile("s_waitcnt lgkmcnt(0)" ::: "memory");
    }
    for (int m = gw; m < MROWS; m += NGW) {
        const f32x4* xr = (const f32x4*)(F.x + (size_t)m * DM) + F.lane; const f32x4* gr = (const f32x4*)F.n0 + F.lane;
        f32x4 v[4]; float s = 0.f;
#pragma unroll
        for (int j = 0; j < 4; ++j) { v[j] = xr[64 * j]; s += (v[j][0] * v[j][0] + v[j][1] * v[j][1]) + (v[j][2] * v[j][2] + v[j][3] * v[j][3]); }
        const float rstd = 1.0f / sqrtf(wave_sum(s) * (1.0f / DM) + EPS);
        u32x2* o8 = (u32x2*)(F.HB + (size_t)m * DM) + F.lane;
#pragma unroll
        for (int j = 0; j < 4; ++j) { const f32x4 gg = gr[64 * j]; u32x2 w; w.x = cvt_pk_bf16(v[j][0] * rstd * gg[0], v[j][1] * rstd * gg[1]); w.y = cvt_pk_bf16(v[j][2] * rstd * gg[2], v[j][3] * rstd * gg[3]); o8[64 * j] = w; }
    }
}

__device__ __forceinline__ bf16x8 rot_negre(const bf16x8 x) {
    u32x4 d = __builtin_bit_cast(u32x4, x);
#pragma unroll
    for (int i = 0; i < 4; ++i) d[i] = __builtin_amdgcn_alignbit(d[i], d[i], 16) ^ 0x80000000u;
    return __builtin_bit_cast(bf16x8, d);
}
__device__ __forceinline__ int f3swz(int R3) { return (R3 & 8) | ((R3 & 7) ^ ((R3 >> 3) & 7)); }
__device__ __forceinline__ void p2_fft(Frame& F) {
    LAS unsigned char* D = F.lds; LAS unsigned char* CM = F.lds + 131072;
    const int tid = F.tid, lane = F.lane, w = F.wave, fr = lane & 15, fq = lane >> 4;
    for (int e = tid; e < 4096; e += NTHREADS) { const int k = e >> 6, n = e & 63; float s, c; sincospif((float)((k * n) & 63) * (1.0f / 32.0f), &s, &c);
        *(LAS unsigned*)(CM + k * 256 + (((n >> 2) ^ (k & 15)) * 16) + (n & 3) * 4) = cvt_pk_bf16(c * 0.125f, s * 0.125f); }
    __syncthreads();
    for (int item = F.bx; item < 1024; item += F.G) {
        int lanev = lane; asm volatile("" : "+v"(lanev));
        const int frv = lanev & 15, fqv = lanev >> 4, tidv = w * 64 + lanev;
        const int bg = item >> 4, slab = item & 15;
        const size_t ibase = ((size_t)bg * 16 + slab) * (4096 * 16);
        const bf16_t* Zs = F.BA + ibase; const bf16_t* Gs = F.BB + ibase; bf16_t* Ys = F.BC + ibase;
        { const int half = lanev & 1, n2 = w * 8 + ((lanev >> 1) & 7), n1l = (lanev >> 4) & 3;
            u32x4 v[16];
#pragma unroll
            for (int i = 0; i < 16; ++i) { const int tok = (i * 4 + n1l) * 64 + n2; v[i] = *(const u32x4*)(Zs + tok * 16 + half * 8); }
#pragma unroll
            for (int i = 0; i < 16; ++i) { const int n1 = i * 4 + n1l;
#pragma unroll
                for (int d = 0; d < 4; ++d) { const int R1 = (half * 4 + d) * 64 + n2; *(LAS unsigned*)(D + R1 * 256 + (((n1 >> 2) ^ (R1 & 15)) * 16) + (n1 & 3) * 4) = v[i][d]; } } }
        __syncthreads();
        f32x4 aR[4][4], aI[4][4];
#pragma unroll
        for (int a = 0; a < 4; ++a)
#pragma unroll
            for (int kb = 0; kb < 4; ++kb) { aR[a][kb] = (f32x4){0.f, 0.f, 0.f, 0.f}; aI[a][kb] = (f32x4){0.f, 0.f, 0.f, 0.f}; }
#pragma unroll 1
        for (int ks = 0; ks < 4; ++ks) { const int ch = ((ks * 4 + fqv) ^ frv) * 16;
            bf16x8 Y[4], X[4];
#pragma unroll
            for (int kb = 0; kb < 4; ++kb) Y[kb] = *(const LAS bf16x8*)(CM + (kb * 16 + frv) * 256 + ch);
#pragma unroll
            for (int a = 0; a < 4; ++a) X[a] = *(const LAS bf16x8*)(D + (w * 64 + a * 16 + frv) * 256 + ch);
#pragma unroll
            for (int a = 0; a < 4; ++a) { const bf16x8 Xs = rot_negre(X[a]);
#pragma unroll
                for (int kb = 0; kb < 4; ++kb) { aR[a][kb] = __builtin_amdgcn_mfma_f32_16x16x32_bf16(X[a], Y[kb], aR[a][kb], 0, 0, 0); aI[a][kb] = __builtin_amdgcn_mfma_f32_16x16x32_bf16(Xs, Y[kb], aI[a][kb], 0, 0, 0); } } }
        __syncthreads();
#pragma unroll
        for (int a = 0; a < 4; ++a)
#pragma unroll
            for (int kb = 0; kb < 4; ++kb) { const int k1 = kb * 16 + frv, R3 = k1 * 8 + w; float o[8];
#pragma unroll
                for (int v = 0; v < 4; ++v) { const int n2 = a * 16 + fqv * 4 + v; const float ang = (float)((n2 * k1) & 4095) * (1.0f / 4096.0f);
                    const float c = __builtin_amdgcn_cosf(ang), s = __builtin_amdgcn_sinf(ang), tr = aR[a][kb][v], ti = aI[a][kb][v];
                    o[2 * v] = tr * c + ti * s; o[2 * v + 1] = ti * c - tr * s; }
                u32x4 pk; pk.x = cvt_pk_bf16(o[0], o[1]); pk.y = cvt_pk_bf16(o[2], o[3]); pk.z = cvt_pk_bf16(o[4], o[5]); pk.w = cvt_pk_bf16(o[6], o[7]);
                *(LAS u32x4*)(D + R3 * 256 + (((a * 4 + fqv) ^ f3swz(R3)) * 16)) = pk; }
        __syncthreads();
        f32x4 c3[4][4], cI[4][4];
#pragma unroll
        for (int a = 0; a < 4; ++a)
#pragma unroll
            for (int kb = 0; kb < 4; ++kb) { c3[a][kb] = (f32x4){0.f, 0.f, 0.f, 0.f}; cI[a][kb] = (f32x4){0.f, 0.f, 0.f, 0.f}; }
#pragma unroll 1
        for (int ks = 0; ks < 4; ++ks) {
            bf16x8 Y[4], X[4];
#pragma unroll
            for (int kb = 0; kb < 4; ++kb) Y[kb] = *(const LAS bf16x8*)(CM + (kb * 16 + frv) * 256 + (((ks * 4 + fqv) ^ frv) * 16));
#pragma unroll
            for (int jj = 0; jj < 4; ++jj) { const int R3 = (w * 4 + jj) * 16 + frv; X[jj] = *(const LAS bf16x8*)(D + R3 * 256 + (((ks * 4 + fqv) ^ f3swz(R3)) * 16)); }
#pragma unroll
            for (int jj = 0; jj < 4; ++jj) {
#pragma unroll
                for (int kb = 0; kb < 4; ++kb) c3[jj][kb] = __builtin_amdgcn_mfma_f32_16x16x32_bf16(X[jj], Y[kb], c3[jj][kb], 0, 0, 0);
                if (slab == 0) { const bf16x8 Xs = rot_negre(X[jj]);
#pragma unroll
                    for (int kb = 0; kb < 4; ++kb) cI[jj][kb] = __builtin_amdgcn_mfma_f32_16x16x32_bf16(Xs, Y[kb], cI[jj][kb], 0, 0, 0); } } }
        __syncthreads();
#pragma unroll
        for (int jj = 0; jj < 4; ++jj)
#pragma unroll
            for (int kb = 0; kb < 4; ++kb) { const int k1 = 2 * (w * 4 + jj) + (fqv >> 1), k2 = kb * 16 + frv, k = k1 + 64 * k2;
                u32x2 pk; pk.x = cvt_pk_bf16(c3[jj][kb][0], c3[jj][kb][1]); pk.y = cvt_pk_bf16(c3[jj][kb][2], c3[jj][kb][3]);
                *(LAS u32x2*)(D + (k + k2) * 16 + (fqv & 1) * 8) = pk;
                if (slab == 0 && (fqv & 1) == 0) *(LAS float*)(D + 98304 + k * 4) = cI[jj][kb][0]; }
        __syncthreads();
#pragma unroll 4
        for (int i = 0; i < 16; ++i) { const int q = tidv + NTHREADS * i, k = q >> 1, half = q & 1, km = (4096 - k) & 4095;
            const u32x4 a = *(const LAS u32x4*)(D + (k + (k >> 6)) * 16), bm = *(const LAS u32x4*)(D + (km + (km >> 6)) * 16);
            const u32x4 gt = *(const u32x4*)(Gs + k * 16 + half * 8);
            const u32x4 src = half ? bm : a; float vals[8];
#pragma unroll
            for (int d = 0; d < 4; ++d) { vals[2 * d] = bf_lo(src[d]); vals[2 * d + 1] = bf_hi(src[d]); }
            if (slab == 0) { if (half == 0) vals[0] = 0.5f * (bf_lo(a[0]) + bf_lo(bm[0])); else vals[0] = 0.5f * (*(const LAS float*)(D + 98304 + k * 4) + *(const LAS float*)(D + 98304 + km * 4)); }
            u32x4 o;
#pragma unroll
            for (int d = 0; d < 4; ++d) o[d] = cvt_pk_bf16(vals[2 * d] * bf_lo(gt[d]), vals[2 * d + 1] * bf_hi(gt[d]));
            *(u32x4*)(Ys + k * 16 + half * 8) = o; }
        __syncthreads();
    }
}

__device__ __forceinline__ int vswz(int row) { return (row & 15) ^ ((row >> 5) & 3); }
__device__ __forceinline__ void p5_sgu(Frame& F) {
    LAS unsigned char* VT = F.lds; LAS unsigned char* WS = F.lds + 65536;
    const int tid = F.tid, lane = F.lane, w = F.wave, fr = lane & 15, fq = lane >> 4;
    for (int item = F.bx; item < 2048; item += F.G) {
        int lanev = lane; asm volatile("" : "+v"(lanev));
        const int frv = lanev & 15, fqv = lanev >> 4, tidv = w * 64 + lanev;
        const int g = item & 7, n = (item >> 3) & 31, b = item >> 8, row0 = b * 4096 + n * 128, col0 = g * 256;
        u32x4 uu[8], zz[8];
#pragma unroll
        for (int jp = 0; jp < 8; ++jp) { const size_t off = (size_t)(row0 + jp * 16 + frv) * EI + col0 + w * 32 + fqv * 8; uu[jp] = *(const u32x4*)(F.BA + off); zz[jp] = *(const u32x4*)(F.BC + off); }
#pragma unroll
        for (int i = 0; i < 4; ++i) { const int idx = tidv + NTHREADS * i, p = idx >> 4, qc = idx & 15; const float* src = F.wsp + ((size_t)g * 128 + p) * 128 + qc * 8;
            const f32x4 a0 = *(const f32x4*)src, a1 = *(const f32x4*)(src + 4);
            *(LAS u32x4*)(WS + p * 256 + ((qc ^ (p & 15)) * 16)) = pack8(a0, a1); }
        { const int c8 = tidv & 31; float gam[8], bet[8];
            { const f32x4 g0 = *(const f32x4*)(F.lng + col0 + c8 * 8), g1 = *(const f32x4*)(F.lng + col0 + c8 * 8 + 4), b0 = *(const f32x4*)(F.lnb + col0 + c8 * 8), b1 = *(const f32x4*)(F.lnb + col0 + c8 * 8 + 4);
#pragma unroll
                for (int i = 0; i < 4; ++i) { gam[i] = g0[i]; gam[4 + i] = g1[i]; bet[i] = b0[i]; bet[4 + i] = b1[i]; } }
#pragma unroll
            for (int j = 0; j < 4; ++j) { const int q = 2 * ((tidv >> 5) + 16 * j), r0 = row0 + q;
                const u32x4 va = *(const u32x4*)(F.BB + (size_t)r0 * EI + col0 + c8 * 8), vb = *(const u32x4*)(F.BB + (size_t)(r0 + 1) * EI + col0 + c8 * 8);
                const float mu0 = F.vsum[r0] * (1.0f / EI), mu1 = F.vsum[r0 + 1] * (1.0f / EI);
                const float rs0 = __builtin_amdgcn_rsqf(fmaxf(F.vsq[r0] * (1.0f / EI) - mu0 * mu0, 0.f) + EPS), rs1 = __builtin_amdgcn_rsqf(fmaxf(F.vsq[r0 + 1] * (1.0f / EI) - mu1 * mu1, 0.f) + EPS);
#pragma unroll
                for (int i = 0; i < 8; ++i) { const float x0 = (i & 1) ? bf_hi(va[i >> 1]) : bf_lo(va[i >> 1]), x1 = (i & 1) ? bf_hi(vb[i >> 1]) : bf_lo(vb[i >> 1]);
                    const float y0 = (x0 - mu0) * rs0 * gam[i] + bet[i], y1 = (x1 - mu1) * rs1 * gam[i] + bet[i];
                    const int c = c8 * 8 + i, cl = c & 31, row = (c & ~31) + 16 * ((cl >> 2) & 1) + 4 * (cl >> 3) + (cl & 3);
                    *(LAS unsigned*)(VT + row * 256 + (((q >> 3) ^ vswz(row)) * 16) + (q & 7) * 2) = cvt_pk_bf16(y0, y1); } } }
        __syncthreads();
        f32x4 acc[2][8];
#pragma unroll
        for (int nn = 0; nn < 2; ++nn)
#pragma unroll
            for (int jp = 0; jp < 8; ++jp) acc[nn][jp] = (f32x4){0.f, 0.f, 0.f, 0.f};
#pragma unroll
        for (int ks = 0; ks < 4; ++ks) { bf16x8 X[2], Y[8];
#pragma unroll
            for (int nn = 0; nn < 2; ++nn) { const int row = w * 32 + nn * 16 + frv; X[nn] = *(const LAS bf16x8*)(VT + row * 256 + (((ks * 4 + fqv) ^ vswz(row)) * 16)); }
#pragma unroll
            for (int jp = 0; jp < 8; ++jp) Y[jp] = *(const LAS bf16x8*)(WS + (jp * 16 + frv) * 256 + (((ks * 4 + fqv) ^ frv) * 16));
#pragma unroll
            for (int nn = 0; nn < 2; ++nn)
#pragma unroll
                for (int jp = 0; jp < 8; ++jp) acc[nn][jp] = __builtin_amdgcn_mfma_f32_16x16x32_bf16(X[nn], Y[jp], acc[nn][jp], 0, 0, 0); }
#pragma unroll
        for (int jp = 0; jp < 8; ++jp) { const int p = jp * 16 + frv; const float bs = F.bsp[g * 128 + p]; u32x4 o;
#pragma unroll
            for (int d = 0; d < 4; ++d) { const f32x4 a = acc[d >> 1][jp]; const float m0 = a[(d & 1) * 2] + bs, m1 = a[(d & 1) * 2 + 1] + bs;
                o[d] = cvt_pk_bf16(bf_lo(uu[jp][d]) * m0 * bf_lo(zz[jp][d]), bf_hi(uu[jp][d]) * m1 * bf_hi(zz[jp][d])); }
            *(u32x4*)(F.BA + (size_t)(row0 + p) * EI + col0 + w * 32 + fqv * 8) = o; }
        __syncthreads();
    }
}

__device__ __forceinline__ void p7_final(Frame& F) {
    const int gw = F.bx * NWAVES + F.wave, NGW = F.G * NWAVES;
    for (int m = gw; m < MROWS; m += NGW) {
        f32x4* xr = (f32x4*)(F.out + (size_t)m * DM) + F.lane; const f32x4* gr = (const f32x4*)F.nf + F.lane;
        const float rstd = __builtin_amdgcn_rsqf(F.ss2[m] * (1.0f / DM) + EPS);
#pragma unroll
        for (int j = 0; j < 4; ++j) { const f32x4 v = xr[64 * j], gg = gr[64 * j]; xr[64 * j] = v * gg * rstd; }
    }
}

__global__ void __launch_bounds__(NTHREADS, 2) fwd_megakernel(Args args) {
    extern __shared__ __attribute__((aligned(16))) unsigned char lds_raw[];
    cg::grid_group grid = cg::this_grid();
    Frame F;
    F.lds = (LAS unsigned char*)lds_raw; F.tid = threadIdx.x; F.lane = F.tid & 63; F.wave = __builtin_amdgcn_readfirstlane(F.tid >> 6); F.G = gridDim.x; F.bx = blockIdx.x;
    F.x = args.in[0]; F.n0 = args.in[1]; F.win0 = args.in[2]; F.wout0 = args.in[3]; F.n1 = args.in[4]; F.win1 = args.in[5]; F.lng = args.in[6]; F.lnb = args.in[7];
    F.wsp = args.in[8]; F.bsp = args.in[9]; F.wout1 = args.in[10]; F.nf = args.in[11]; F.out = args.out;
    unsigned char* ws = args.ws;
    F.ss1 = (float*)(ws + WS_SS1); F.vsum = (float*)(ws + WS_VSUM); F.vsq = (float*)(ws + WS_VSQ); F.ss2 = (float*)(ws + WS_SS2);
    F.W0t = (bf16_t*)(ws + WS_W0T); F.Wo0t = (bf16_t*)(ws + WS_WO0T); F.W1t = (bf16_t*)(ws + WS_W1T); F.Wo1t = (bf16_t*)(ws + WS_WO1T);
    F.HB = (bf16_t*)(ws + WS_HB); F.BA = (bf16_t*)(ws + WS_BUFA); F.BB = (bf16_t*)(ws + WS_BUFB); F.BC = (bf16_t*)(ws + WS_BUFC);

    volatile LAS unsigned* MISC = (volatile LAS unsigned*)(F.lds + MISC_OFF);
    if (F.tid < 32) MISC[F.tid] = 0u;
    __syncthreads();
#ifdef PROBE_A
    unsigned long long ts[9]; int nts = 0;
#define STAMP() do { ts[nts++] = __builtin_amdgcn_s_memrealtime(); } while (0)
#else
#define STAMP() do { } while (0)
#endif
    STAMP();
    p0_prep(F);
    grid.sync();
    XcdBarrier bar = xcd_barrier_post((unsigned*)(ws + WS_BAR), MISC);
    STAMP();
    { pg8::Gemm g{F.HB, F.W0t, MROWS, 4096, DM}; pg8::StaticOrder S; S.init(MROWS, 4096, F.G, F.bx); Epi1 E{F.BA, F.BB};
      pg8::gemm_phase<Epi1, false>(F.lds, g, S, E); }
    xcd_barrier(bar); STAMP();
    p2_fft(F);
    xcd_barrier(bar); STAMP();
    { pg8::Gemm g{F.BC, F.Wo0t, MROWS, DM, EI}; pg8::StaticOrder S; S.init(MROWS, DM, F.G, F.bx); EpiRes<true> E{F.x, F.out, F.HB, F.ss1};
      pg8::gemm_phase<EpiRes<true>, true>(F.lds, g, S, E); }
    xcd_barrier(bar); STAMP();
    { pg8::Gemm g{F.HB, F.W1t, MROWS, 6144, DM}; pg8::StaticOrder S; S.init(MROWS, 6144, F.G, F.bx); Epi3 E{F.ss1, F.BA, F.vsum, F.vsq};
      pg8::gemm_phase<Epi3, false>(F.lds, g, S, E); }
    xcd_barrier(bar); STAMP();
    p5_sgu(F);
    xcd_barrier(bar); STAMP();
    { pg8::Gemm g{F.BA, F.Wo1t, MROWS, DM, EI}; pg8::StaticOrder S; S.init(MROWS, DM, F.G, F.bx); EpiRes<false> E{F.out, F.out, nullptr, F.ss2};
      pg8::gemm_phase<EpiRes<false>, false>(F.lds, g, S, E); }
    xcd_barrier(bar); STAMP();
    p7_final(F);
#ifdef PROBE_A
    xcd_barrier(bar); STAMP();
    if (F.bx == 0) { const float ta = (float)(ts[PROBE_A + 1] - ts[PROBE_A]) * 0.01f, tb = (float)(ts[PROBE_B + 1] - ts[PROBE_B]) * 0.0001f;
        for (int i = 1 + F.tid; i < MROWS * DM / 16; i += NTHREADS) F.out[i] += tb;
        if (F.tid == 0) F.out[0] = ta; }
#endif
}

extern "C" void kernel_launch(void* const* d_in, const int* in_sizes, int n_in, void* d_out, int out_size, void* d_ws, size_t ws_size, hipStream_t stream) {
    static int grid = 0;
    if (!grid) {
        if (n_in != 12 || in_sizes[0] != MROWS * DM || out_size != MROWS * DM || ws_size < WS_END) {
            fprintf(stderr, "kernel_launch: unexpected problem (n_in %d, in0 %d, out %d, ws %zu); nothing launched\n", n_in, in_sizes[0], out_size, ws_size); grid = -1; return; }
        int dev = 0, cus = 0, per_cu = 0;
        if (hipGetDevice(&dev) != hipSuccess || hipDeviceGetAttribute(&cus, hipDeviceAttributeMultiprocessorCount, dev) != hipSuccess) { grid = -1; return; }
        if (hipFuncSetAttribute((const void*)fwd_megakernel, hipFuncAttributeMaxDynamicSharedMemorySize, LDS_BYTES) != hipSuccess) { fprintf(stderr, "kernel_launch: hipFuncSetAttribute failed\n"); grid = -1; return; }
        if (hipOccupancyMaxActiveBlocksPerMultiprocessor(&per_cu, (const void*)fwd_megakernel, NTHREADS, LDS_BYTES) != hipSuccess || per_cu < 1) per_cu = 1;
        grid = cus * per_cu;
    }
    if (grid < 0) return;
    Args a{};
    for (int i = 0; i < 12; ++i) a.in[i] = (const float*)d_in[i];
    a.out = (float*)d_out; a.ws = (unsigned char*)d_ws;
    void* kargs[] = {&a};
    hipError_t e = hipLaunchCooperativeKernel((const void*)fwd_megakernel, dim3(grid), dim3(NTHREADS), kargs, LDS_BYTES, stream);
    if (e != hipSuccess) fprintf(stderr, "kernel_launch: cooperative launch failed: %s (grid %d)\n", hipGetErrorString(e), grid);
}
```

```cpp
#include <hip/hip_runtime.h>
#include <hip/hip_cooperative_groups.h>
#include <cstdio>
#include <cstdint>
namespace cg = cooperative_groups;

#define LAS __attribute__((address_space(3)))
typedef unsigned short bf16_t;
typedef short bf16x8 __attribute__((ext_vector_type(8)));
typedef float f32x4 __attribute__((ext_vector_type(4)));
typedef float f32x2 __attribute__((ext_vector_type(2)));
typedef unsigned u32x4 __attribute__((ext_vector_type(4)));
typedef unsigned u32x2 __attribute__((ext_vector_type(2)));

constexpr int MROWS = 32768, DM = 1024, EI = 2048, SEQ = 4096;
constexpr float EPS = 1e-6f;
constexpr int NTHREADS = 512, NWAVES = 8;
constexpr int LDS_BYTES = 148480;
constexpr size_t MiB = 1u << 20;
constexpr size_t WS_SS1 = 0, WS_VSUM = 128 * 1024, WS_VSQ = 256 * 1024, WS_SS2 = 384 * 1024, WS_BAR = 512 * 1024;
constexpr int MISC_OFF = 147456;
constexpr size_t WS_W0T = 1 * MiB, WS_WO0T = 9 * MiB, WS_W1T = 13 * MiB, WS_WO1T = 25 * MiB;
constexpr size_t WS_HB = 32 * MiB, WS_BUFA = 96 * MiB, WS_BUFB = 224 * MiB, WS_BUFC = 352 * MiB, WS_END = 480 * MiB;

__device__ __forceinline__ unsigned cvt_pk_bf16(float lo, float hi) { unsigned r; asm volatile("v_cvt_pk_bf16_f32 %0, %1, %2" : "=v"(r) : "v"(lo), "v"(hi)); return r; }
__device__ __forceinline__ float bf_lo(unsigned u) { return __uint_as_float(u << 16); }
__device__ __forceinline__ float bf_hi(unsigned u) { return __uint_as_float(u & 0xffff0000u); }
__device__ __forceinline__ float silu_f(float x) { return x * __builtin_amdgcn_rcpf(1.0f + __builtin_amdgcn_exp2f(-1.4426950409f * x)); }
__device__ __forceinline__ float gelu_f(float x) { const float t = x * (1.0f + 0.044715f * x * x); return x * __builtin_amdgcn_rcpf(1.0f + __builtin_amdgcn_exp2f(-2.302208198f * t)); }
__device__ __forceinline__ float wave_sum(float v) {
#pragma unroll
    for (int o = 1; o < 64; o <<= 1) v += __shfl_xor(v, o);
    return v;
}
__host__ __device__ __forceinline__ int chan_of_pos(int p) { const int s = p >> 4, e = p & 15; if (e < 8) return 8 * s + e; const int j = 8 * s + (e - 8); return j == 0 ? 128 : 256 - j; }
__host__ __device__ __forceinline__ int pos_of_chan(int ch) { if (ch < 128) return 16 * (ch >> 3) + (ch & 7); if (ch == 128) return 8; const int j = 256 - ch; return 16 * (j >> 3) + 8 + (j & 7); }

namespace pg8 {
constexpr int BM = 256, BK = 64, HALF = 128, HTB = HALF * BK * 2, STAGE_BYTES = 8 * HTB, NXCD = 8, WGM = 8;
__host__ __device__ __forceinline__ int lds_byte(int r, int c) { const int st = (r >> 4) * 2 + (c >> 5), rr = r & 15, cc = c & 31, ob = rr * 64 + cc * 2; return st * 1024 + (ob ^ (((ob >> 9) & 1) << 5)); }
__host__ __device__ __forceinline__ void stage_rc(int b, int& R, int& C) { const int st = b / 1024, sb = b % 1024, swz = sb ^ (((sb >> 9) & 1) << 5); R = (st >> 1) * 16 + swz / 64; C = (st & 1) * 32 + (swz % 64) / 2; }
__host__ __device__ __forceinline__ int perm32(int rho) { const int n = rho >> 4, i = rho & 15; return 8 * (i >> 2) + 4 * n + (i & 3); }
struct Unit { int pm, pn; };
struct Gemm { const bf16_t* A; const bf16_t* Bt; int M, N, K; };
struct StaticOrder {
    int nM, nN, nwg, G, c;
    __host__ __device__ void init(int M, int N, int G_, int c_) { nM = M / BM; nN = N / BM; nwg = nM * nN; G = G_; c = c_; }
    __host__ __device__ bool next(int i, Unit& u) const {
        const long L = (long)i * G + c; if (L >= nwg) return false;
        int wgid = (int)L; { const int q = nwg / NXCD, r = nwg % NXCD, xcd = wgid % NXCD, off = wgid / NXCD; wgid = (xcd < r ? xcd * (q + 1) : r * (q + 1) + (xcd - r) * q) + off; }
        const int nig = WGM * nN, gid = wgid / nig, fm = gid * WGM, gsz = (nM - fm) < WGM ? (nM - fm) : WGM;
        u.pm = fm + ((wgid % nig) % gsz); u.pn = (wgid % nig) / gsz; return true;
    }
};
template <class Epi, bool ABLK>
__device__ __forceinline__ void gemm_phase(LAS unsigned char* lds, const Gemm g, const StaticOrder& S, const Epi& E) {
    const int tid = threadIdx.x, wid = __builtin_amdgcn_readfirstlane(tid >> 6), lane = tid & 63, wr = wid >> 2, wc = wid & 3, fr = lane & 15, fq = lane >> 4;
    const int K = g.K, nt = K / BK;
    unsigned voffA[2], voffB[2];
#pragma unroll
    for (int i = 0; i < 2; ++i) { int R, C; stage_rc(tid * 16 + i * 8192, R, C); const int Rb = (R & ~31) + perm32(R & 31);
        voffA[i] = ABLK ? (unsigned)((C >> 4) * 65536 + R * 16 + (C & 15)) * 2u : (unsigned)(R * K + C) * 2u; voffB[i] = (unsigned)(Rb * K + C) * 2u; }
    const size_t kstepB = (size_t)(BK * 2), hstepB = (size_t)HALF * K * 2, tstepB = 2 * hstepB;
    const size_t kstepA = ABLK ? (size_t)4 * 65536 * 2 : kstepB, hstepA = ABLK ? (size_t)HALF * 16 * 2 : hstepB;
#define PG8_ABASE(pm) ((const char*)g.A + (ABLK ? ((size_t)((pm) >> 4) * 4096 * 2048 + (size_t)((pm) & 15) * 256 * 16) * 2 : (size_t)(pm) * tstepB))
    const unsigned ldsw = (unsigned)wid * 1024u;
    const int aoff = lds_byte(wr * 64 + fr, fq * 8), boff = lds_byte(wc * 32 + fr, fq * 8);
#define PG8_SA(b, h) (((b) * 2 + (h)) * HTB)
#define PG8_SB(b, h) ((4 + (b) * 2 + (h)) * HTB)
#define PG8_STAGE(bufoff, gbase, voff) do { _Pragma("unroll") for (int _i = 0; _i < 2; ++_i) \
        __builtin_amdgcn_global_load_lds((const unsigned*)((const char*)(gbase) + (voff)[_i]), (LAS unsigned*)(lds + (bufoff) + ldsw + _i * 8192), 16, 0, 0); } while (0)
#define PG8_LDA(dst, b, h) do { _Pragma("unroll") for (int m = 0; m < 4; ++m) _Pragma("unroll") for (int k = 0; k < 2; ++k) dst[m][k] = *(const LAS bf16x8*)(lds + PG8_SA(b, h) + aoff + m * 2048 + k * 1024); } while (0)
#define PG8_LDB(dst, b, h) do { _Pragma("unroll") for (int n = 0; n < 2; ++n) _Pragma("unroll") for (int k = 0; k < 2; ++k) dst[n][k] = *(const LAS bf16x8*)(lds + PG8_SB(b, h) + boff + n * 2048 + k * 1024); } while (0)
#define PG8_MMA(ai, bj, At, Bt) do { __builtin_amdgcn_s_setprio(1); _Pragma("unroll") for (int m = 0; m < 4; ++m) _Pragma("unroll") for (int n = 0; n < 2; ++n) _Pragma("unroll") for (int k = 0; k < 2; ++k) \
        acc[ai][bj][m][n] = __builtin_amdgcn_mfma_f32_16x16x32_bf16(Bt[n][k], At[m][k], acc[ai][bj][m][n], 0, 0, 0); __builtin_amdgcn_s_setprio(0); } while (0)
#define PG8_WAIT_V(n) asm volatile("s_waitcnt vmcnt(" #n ")" ::: "memory")
#define PG8_WAIT_L(n) asm volatile("s_waitcnt lgkmcnt(" #n ")" ::: "memory")
#define PG8_BAR __builtin_amdgcn_s_barrier()
#define PG8_SCHED __builtin_amdgcn_sched_barrier(0)
    Unit cur, nxt; int ui = 0;
    if (!S.next(0, cur)) return;
    f32x4 acc[2][2][4][2];
#pragma unroll
    for (int a = 0; a < 2; ++a)
#pragma unroll
        for (int b = 0; b < 2; ++b)
#pragma unroll
            for (int m = 0; m < 4; ++m)
#pragma unroll
                for (int n = 0; n < 2; ++n) acc[a][b][m][n] = (f32x4){0.f, 0.f, 0.f, 0.f};
    bf16x8 At[4][2], B0[2][2], B1[2][2];
    const char* cA = PG8_ABASE(cur.pm); const char* cB = (const char*)g.Bt + (size_t)cur.pn * tstepB;
    PG8_STAGE(PG8_SB(0, 0), cB, voffB); PG8_STAGE(PG8_SB(0, 1), cB + hstepB, voffB); PG8_STAGE(PG8_SA(0, 0), cA, voffA); PG8_STAGE(PG8_SA(0, 1), cA + hstepA, voffA);
    if (wr == 1) PG8_BAR;
    PG8_WAIT_V(2); PG8_BAR;
    PG8_STAGE(PG8_SB(1, 0), cB + kstepB, voffB); PG8_STAGE(PG8_SA(1, 0), cA + kstepA, voffA); PG8_STAGE(PG8_SB(1, 1), cB + hstepB + kstepB, voffB);
    PG8_WAIT_V(6); PG8_BAR;
    for (;;) {
        const bool has_next = S.next(ui + 1, nxt);
        const char* nA = has_next ? PG8_ABASE(nxt.pm) : cA; const char* nB = has_next ? (const char*)g.Bt + (size_t)nxt.pn * tstepB : cB;
        for (int t = 0; t < nt; t += 2) {
            const bool last = (t == nt - 2);
            const char* a1 = cA + (size_t)(t + 1) * kstepA;
            const char* a2 = last ? nA : cA + (size_t)(t + 2) * kstepA; const char* b2 = last ? nB : cB + (size_t)(t + 2) * kstepB;
            const char* a3 = a2 + kstepA; const char* b3 = b2 + kstepB;
            PG8_LDB(B0, 0, 0); PG8_LDB(B1, 0, 1); PG8_SCHED; PG8_LDA(At, 0, 0); PG8_STAGE(PG8_SA(1, 1), a1 + hstepA, voffA);
            PG8_WAIT_V(8); PG8_WAIT_L(0); PG8_BAR; PG8_MMA(0, 0, At, B0); PG8_MMA(0, 1, At, B1); PG8_BAR; PG8_SCHED;
            PG8_LDA(At, 0, 1); PG8_STAGE(PG8_SB(0, 0), b2, voffB); PG8_STAGE(PG8_SB(0, 1), b2 + hstepB, voffB); PG8_STAGE(PG8_SA(0, 0), a2, voffA);
            PG8_WAIT_V(8); PG8_WAIT_L(0); PG8_BAR; PG8_MMA(1, 0, At, B0); PG8_MMA(1, 1, At, B1); PG8_BAR; PG8_SCHED;
            PG8_LDB(B0, 1, 0); PG8_LDB(B1, 1, 1); PG8_SCHED; PG8_LDA(At, 1, 0); PG8_STAGE(PG8_SA(0, 1), a2 + hstepA, voffA);
            PG8_WAIT_V(8); PG8_WAIT_L(0); PG8_BAR; PG8_MMA(0, 0, At, B0); PG8_MMA(0, 1, At, B1); PG8_BAR; PG8_SCHED;
            PG8_LDA(At, 1, 1); PG8_STAGE(PG8_SB(1, 0), b3, voffB); PG8_STAGE(PG8_SB(1, 1), b3 + hstepB, voffB); PG8_STAGE(PG8_SA(1, 0), a3, voffA);
            PG8_WAIT_V(8); PG8_WAIT_L(0); PG8_BAR; PG8_MMA(1, 0, At, B0); PG8_MMA(1, 1, At, B1); PG8_BAR; PG8_SCHED;
        }
        if (wr == 0) PG8_BAR;
        E(acc, cur, wr, wc, fr, fq);
        if (!has_next) break;
#pragma unroll
        for (int a = 0; a < 2; ++a)
#pragma unroll
            for (int b = 0; b < 2; ++b)
#pragma unroll
                for (int m = 0; m < 4; ++m)
#pragma unroll
                    for (int n = 0; n < 2; ++n) acc[a][b][m][n] = (f32x4){0.f, 0.f, 0.f, 0.f};
        cur = nxt; cA = nA; cB = nB; ++ui;
        if (wr == 1) PG8_BAR;
    }
    PG8_WAIT_V(0);
    PG8_BAR;
#undef PG8_ABASE
#undef PG8_SA
#undef PG8_SB
#undef PG8_STAGE
#undef PG8_LDA
#undef PG8_LDB
#undef PG8_MMA
#undef PG8_WAIT_V
#undef PG8_WAIT_L
#undef PG8_BAR
#undef PG8_SCHED
}
}

__device__ __forceinline__ u32x4 pack8(const f32x4 v0, const f32x4 v1) { u32x4 w; w.x = cvt_pk_bf16(v0[0], v0[1]); w.y = cvt_pk_bf16(v0[2], v0[3]); w.z = cvt_pk_bf16(v1[0], v1[1]); w.w = cvt_pk_bf16(v1[2], v1[3]); return w; }

struct Epi1 {
    bf16_t* Z; bf16_t* SZ;
    __device__ __forceinline__ void operator()(const f32x4 (&acc)[2][2][4][2], const pg8::Unit& u, int wr, int wc, int fr, int fq) const {
        const int b = u.pm >> 4, t0 = (u.pm & 15) * 256 + wr * 64 + fr; const bool gate = u.pn >= 8; const int g = u.pn & 7;
        bf16_t* base = (gate ? SZ : Z) + (size_t)(b * 8 + g) * (16 * 4096 * 16);
#pragma unroll
        for (int ai = 0; ai < 2; ++ai)
#pragma unroll
            for (int m = 0; m < 4; ++m) { const int t = t0 + ai * 128 + m * 16;
#pragma unroll
                for (int bj = 0; bj < 2; ++bj) { const int cgp = bj * 128 + wc * 32 + fq * 8, s = cgp >> 4, e0 = cgp & 8;
                    f32x4 v0 = acc[ai][bj][m][0], v1 = acc[ai][bj][m][1];
                    if (gate) {
#pragma unroll
                        for (int j = 0; j < 4; ++j) { v0[j] = silu_f(v0[j]); v1[j] = silu_f(v1[j]); } }
                    *(u32x4*)(base + ((size_t)s * 4096 + t) * 16 + e0) = pack8(v0, v1); } }
    }
};
template <bool FIRST> struct EpiRes {
    const float* XIN; bf16_t* XB; float* SS;
    __device__ __forceinline__ void operator()(const f32x4 (&acc)[2][2][4][2], const pg8::Unit& u, int wr, int wc, int fr, int fq) const {
        const int row0 = u.pm * 256 + wr * 64 + fr, col0 = u.pn * 256 + wc * 32 + fq * 8;
#pragma unroll
        for (int ai = 0; ai < 2; ++ai)
#pragma unroll
            for (int m = 0; m < 4; ++m) { const int row = row0 + ai * 128 + m * 16; float ss = 0.f;
#pragma unroll
                for (int bj = 0; bj < 2; ++bj) { const size_t off = (size_t)row * DM + col0 + bj * 128; f32x4 x0, x1;
                    if (FIRST) { x0 = *(const f32x4*)(XIN + off); x1 = *(const f32x4*)(XIN + off + 4); }
                    else { const u32x4 r = *(const u32x4*)(XB + off); x0 = (f32x4){bf_lo(r.x), bf_hi(r.x), bf_lo(r.y), bf_hi(r.y)}; x1 = (f32x4){bf_lo(r.z), bf_hi(r.z), bf_lo(r.w), bf_hi(r.w)}; }
                    const f32x4 v0 = acc[ai][bj][m][0] + x0, v1 = acc[ai][bj][m][1] + x1;
                    *(u32x4*)(XB + off) = pack8(v0, v1);
                    ss += (v0[0] * v0[0] + v0[1] * v0[1]) + (v0[2] * v0[2] + v0[3] * v0[3]) + (v1[0] * v1[0] + v1[1] * v1[1]) + (v1[2] * v1[2] + v1[3] * v1[3]); }
                ss += __shfl_xor(ss, 16); ss += __shfl_xor(ss, 32);
                if (fq == 0) atomicAdd(SS + row, ss); }
    }
};
struct Epi3 {
    const float* SS1; bf16_t* U; float* VSUM; float* VSQ;
    __device__ __forceinline__ void operator()(const f32x4 (&acc)[2][2][4][2], const pg8::Unit& u, int wr, int wc, int fr, int fq) const {
        const int row0 = u.pm * 256 + wr * 64 + fr, which = u.pn >> 3, col0 = (u.pn & 7) * 256 + wc * 32 + fq * 8;
        bf16_t* dst = U + (size_t)which * ((WS_BUFB - WS_BUFA) / 2);
#pragma unroll
        for (int ai = 0; ai < 2; ++ai)
#pragma unroll
            for (int m = 0; m < 4; ++m) { const int row = row0 + ai * 128 + m * 16;
                const float rs = __builtin_amdgcn_rsqf(SS1[row] * (1.0f / DM) + EPS); float s1 = 0.f, s2 = 0.f;
#pragma unroll
                for (int bj = 0; bj < 2; ++bj) { f32x4 v0 = acc[ai][bj][m][0] * rs, v1 = acc[ai][bj][m][1] * rs;
                    if (which == 2) {
#pragma unroll
                        for (int j = 0; j < 4; ++j) { v0[j] = silu_f(v0[j]); v1[j] = silu_f(v1[j]); } }
                    else {
#pragma unroll
                        for (int j = 0; j < 4; ++j) { v0[j] = gelu_f(v0[j]); v1[j] = gelu_f(v1[j]); } }
                    if (which == 1) { s1 += (v0[0] + v0[1]) + (v0[2] + v0[3]) + (v1[0] + v1[1]) + (v1[2] + v1[3]);
                        s2 += (v0[0] * v0[0] + v0[1] * v0[1]) + (v0[2] * v0[2] + v0[3] * v0[3]) + (v1[0] * v1[0] + v1[1] * v1[1]) + (v1[2] * v1[2] + v1[3] * v1[3]); }
                    *(u32x4*)(dst + (size_t)row * EI + col0 + bj * 128) = pack8(v0, v1); }
                if (which == 1) { s1 += __shfl_xor(s1, 16); s1 += __shfl_xor(s1, 32); s2 += __shfl_xor(s2, 16); s2 += __shfl_xor(s2, 32);
                    if (fq == 0) { atomicAdd(VSUM + row, s1); atomicAdd(VSQ + row, s2); } } }
    }
};


#define XB_TMO      128
#define XB_XCNT(j)  (256  + 64 * (j))
#define XB_XSUB(j)  (1280 + 64 * (j))
#define XB_XGEN(j)  (2304 + 64 * (j))
#define XB_TOP      3328
#define XB_TOPGEN   3392
#define XCD_BAR_WORDS 3456
#define XB_SPIN_CAP (1u << 18)
__device__ __forceinline__ unsigned xb_ld(unsigned* p)              { return __hip_atomic_load(p, __ATOMIC_RELAXED, __HIP_MEMORY_SCOPE_AGENT); }
__device__ __forceinline__ unsigned xb_add(unsigned* p, unsigned v) { return __hip_atomic_fetch_add(p, v, __ATOMIC_RELAXED, __HIP_MEMORY_SCOPE_AGENT); }
__device__ __forceinline__ unsigned xb_xcc_id() { return (unsigned)__builtin_amdgcn_s_getreg((3 << 11) | 20) & 0xFu; }
#define XB_SPIN(cond, bar) do { unsigned _sp = 0; while (cond) { __builtin_amdgcn_s_sleep(1); \
    if ((++_sp & 255u) == 0u) { if (xb_ld(&(bar)[XB_TMO])) break; if (_sp > XB_SPIN_CAP) { atomicAdd(&(bar)[XB_TMO], 1u); break; } } } } while (0)
struct XcdBarrier { unsigned* bar; unsigned x; volatile LAS unsigned* st; };
__device__ __forceinline__ XcdBarrier xcd_barrier_post(unsigned* bar, volatile LAS unsigned* st) {
    XcdBarrier b; b.bar = bar; b.x = xb_xcc_id(); b.st = st;
    if (threadIdx.x == 0) (void)xb_add(&bar[XB_XCNT(b.x)], 1u);
    return b;
}
__device__ __forceinline__ void xcd_barrier_complete(unsigned* bar, unsigned x, unsigned& nloc, unsigned& nx) {
    const unsigned G = gridDim.x * gridDim.y * gridDim.z;
    unsigned sum, cnt, mine, sp = 0u;
    for (;;) {
        sum = 0u; cnt = 0u; mine = 0u;
#pragma unroll
        for (unsigned j = 0; j < 16; ++j) { const unsigned c = xb_ld(&bar[XB_XCNT(j)]); sum += c; cnt += (c > 0u) ? 1u : 0u; mine = (j == x) ? c : mine; }
        if (sum == G) break;
        __builtin_amdgcn_s_sleep(1);
        if ((++sp & 255u) == 0u) { if (xb_ld(&bar[XB_TMO])) break; if (sp > XB_SPIN_CAP) { atomicAdd(&bar[XB_TMO], 1u); break; } }
    }
    nloc = mine > 0u ? mine : 1u; nx = cnt > 0u ? cnt : 1u;
}
__device__ __forceinline__ void xcd_barrier(const XcdBarrier& b) {
    asm volatile("s_waitcnt vmcnt(0)" ::: "memory");
    __syncthreads();
    if (threadIdx.x == 0) {
        unsigned* bar = b.bar;
        __builtin_amdgcn_s_waitcnt(0);
        unsigned nloc = b.st[0], nx = b.st[1];
        if (nloc == 0u) { xcd_barrier_complete(bar, b.x, nloc, nx); b.st[0] = nloc; b.st[1] = nx; }
        const unsigned old = xb_add(&bar[XB_XSUB(b.x)], 1u);
        const unsigned gen = old / nloc;
        if (old + 1u == (gen + 1u) * nloc) {
            __builtin_amdgcn_fence(__ATOMIC_RELEASE, "agent");
            asm volatile("s_waitcnt vmcnt(0)" ::: "memory");
            const unsigned og = xb_add(&bar[XB_TOP], 1u);
            const unsigned tg = og / nx;
            if (og + 1u == (tg + 1u) * nx) xb_add(&bar[XB_TOPGEN], 1u);
            else XB_SPIN(xb_ld(&bar[XB_TOPGEN]) == tg, bar);
            __builtin_amdgcn_fence(__ATOMIC_ACQUIRE, "agent");
            xb_add(&bar[XB_XGEN(b.x)], 1u);
            asm volatile("s_waitcnt vmcnt(0)" ::: "memory");
        } else {
            XB_SPIN(xb_ld(&bar[XB_XGEN(b.x)]) == gen, bar);
            __builtin_amdgcn_fence(__ATOMIC_ACQUIRE, "agent");
            asm volatile("s_waitcnt vmcnt(0)" ::: "memory");
        }
    }
    __syncthreads();
}

struct Args { const float* in[12]; float* out; unsigned char* ws; };
struct Frame {
    LAS unsigned char* lds; int tid, lane, wave, G, bx;
    const float *x, *n0, *win0, *wout0, *n1, *win1, *lng, *lnb, *wsp, *bsp, *wout1, *nf; float* out;
    float *ss1, *vsum, *vsq, *ss2;
    bf16_t *W0t, *Wo0t, *W1t, *Wo1t, *HB, *BA, *BB, *BC;
};

__device__ __forceinline__ void p0_transpose_item(const float* W, int N, bf16_t* WT, int Kd, LAS float* scr, int k0, int n0, int lane, int mode, const float* kscale) {
#pragma unroll
    for (int i = 0; i < 32; ++i) { const int kk = 2 * i + (lane >> 5), k = k0 + kk; const int sr = (mode == 2) ? ((k & ~255) + chan_of_pos(k & 255)) : k;
        float v = W[(size_t)sr * N + n0 + (lane & 31)]; if (mode == 3) v *= kscale[k]; scr[kk * 33 + (lane & 31)] = v; }
    asm volatile("s_waitcnt lgkmcnt(0)" ::: "memory");
    const int c = lane & 7;
#pragma unroll
    for (int j = 0; j < 4; ++j) { const int n = (lane >> 3) + 8 * j; const LAS float* s = scr + (8 * c) * 33 + n; const int ns = n0 + n;
        const int dr = (mode == 1) ? (2048 + (ns & 0x700) + pos_of_chan(ns & 255)) : ns;
        u32x4 o; o.x = cvt_pk_bf16(s[0 * 33], s[1 * 33]); o.y = cvt_pk_bf16(s[2 * 33], s[3 * 33]); o.z = cvt_pk_bf16(s[4 * 33], s[5 * 33]); o.w = cvt_pk_bf16(s[6 * 33], s[7 * 33]);
        *(u32x4*)(WT + (size_t)dr * Kd + k0 + 8 * c) = o; }
    asm volatile("s_waitcnt lgkmcnt(0)" ::: "memory");
}
__device__ __forceinline__ void p0_prep(Frame& F) {
    LAS float* scr = (LAS float*)(F.lds + F.wave * 16384);
    LAS float* costab = (LAS float*)(F.lds + 131072);
    if (F.tid < 256) costab[F.tid] = cospif((float)F.tid * (1.0f / 128.0f)) * (1.0f / 16.0f);
    __syncthreads();
    const int gw = F.bx * NWAVES + F.wave, NGW = F.G * NWAVES;
    for (int i = F.bx * NTHREADS + F.tid; i < 4 * MROWS; i += F.G * NTHREADS) F.ss1[i] = 0.f;
    constexpr int I_A = 16 * 64, I_B = 32 * 32, I_C = 16 * 192, I_D = 32 * 32;
    for (int it = gw; it < I_A + I_B + I_C + I_D; it += NGW) {
        int r = it;
        if (r < I_A) { const int kb = r >> 6, nb = r & 63; p0_transpose_item(F.win0, 4096, F.W0t, 1024, scr, kb * 64, 2048 + nb * 32, F.lane, 1, nullptr); continue; } r -= I_A;
        if (r < I_B) { const int kb = r >> 5, nb = r & 31; p0_transpose_item(F.wout0, 1024, F.Wo0t, 2048, scr, kb * 64, nb * 32, F.lane, 2, nullptr); continue; } r -= I_B;
        if (r < I_C) { const int kb = r / 192, nb = r % 192; p0_transpose_item(F.win1, 6144, F.W1t, 1024, scr, kb * 64, nb * 32, F.lane, 3, F.n1); continue; } r -= I_C;
        { const int kb = r >> 5, nb = r & 31; p0_transpose_item(F.wout1, 1024, F.Wo1t, 2048, scr, kb * 64, nb * 32, F.lane, 0, nullptr); }
    }
    for (int task = gw; task < 4096; task += NGW) {
        const int kb = task >> 5, g = (task >> 2) & 7, pc = task & 3, P = pc * 64 + F.lane;
        const int jeff = (P == 1) ? 128 : (P >> 1), phase = (P >= 3 && (P & 1)) ? 64 : 0;
        const float* wp = F.win0 + (size_t)(kb * 8) * 4096 + g * 256;
#pragma unroll
        for (int i = 0; i < 8; ++i) *(LAS f32x4*)(scr + i * 256 + F.lane * 4) = *(const f32x4*)(wp + (size_t)i * 4096 + F.lane * 4);
        asm volatile("s_waitcnt vmcnt(0) lgkmcnt(0)" ::: "memory");
        float a[8];
#pragma unroll
        for (int i = 0; i < 8; ++i) a[i] = 0.f;
        for (int c = 0; c < 256; c += 4) {
            float t[4];
#pragma unroll
            for (int j = 0; j < 4; ++j) t[j] = costab[(jeff * (c + j) + phase) & 255];
#pragma unroll
            for (int i = 0; i < 8; ++i) { const f32x4 w = *(const LAS f32x4*)(scr + i * 256 + c); a[i] += w[0] * t[0]; a[i] += w[1] * t[1]; a[i] += w[2] * t[2]; a[i] += w[3] * t[3]; }
        }
        u32x4 o; o.x = cvt_pk_bf16(a[0], a[1]); o.y = cvt_pk_bf16(a[2], a[3]); o.z = cvt_pk_bf16(a[4], a[5]); o.w = cvt_pk_bf16(a[6], a[7]);
        *(u32x4*)(F.W0t + (size_t)(g * 256 + P) * 1024 + kb * 8) = o;
        asm volatile("s_waitcnt lgkmcnt(0)" ::: "memory");
    }
    { const f32x4* gr = (const f32x4*)F.n0 + F.lane; f32x4 gg[4];
#pragma unroll
      for (int j = 0; j < 4; ++j) gg[j] = gr[64 * j];
      for (int m0 = gw * 2; m0 < MROWS; m0 += NGW * 2) {
        f32x4 v[2][4]; float s[2];
#pragma unroll
        for (int r = 0; r < 2; ++r) { const f32x4* xr = (const f32x4*)(F.x + (size_t)(m0 + r) * DM) + F.lane;
#pragma unroll
            for (int j = 0; j < 4; ++j) v[r][j] = xr[64 * j]; }
#pragma unroll
        for (int r = 0; r < 2; ++r) { s[r] = 0.f;
#pragma unroll
            for (int j = 0; j < 4; ++j) s[r] += (v[r][j][0] * v[r][j][0] + v[r][j][1] * v[r][j][1]) + (v[r][j][2] * v[r][j][2] + v[r][j][3] * v[r][j][3]); }
#pragma unroll
        for (int r = 0; r < 2; ++r) { const float rstd = 1.0f / sqrtf(wave_sum(s[r]) * (1.0f / DM) + EPS);
            u32x2* o8 = (u32x2*)(F.HB + (size_t)(m0 + r) * DM) + F.lane;
#pragma unroll
            for (int j = 0; j < 4; ++j) { u32x2 w; w.x = cvt_pk_bf16(v[r][j][0] * rstd * gg[j][0], v[r][j][1] * rstd * gg[j][1]); w.y = cvt_pk_bf16(v[r][j][2] * rstd * gg[j][2], v[r][j][3] * rstd * gg[j][3]); o8[64 * j] = w; } }
      } }
}

__device__ __forceinline__ bf16x8 rot_negre(const bf16x8 x) {
    u32x4 d = __builtin_bit_cast(u32x4, x);
#pragma unroll
    for (int i = 0; i < 4; ++i) d[i] = __builtin_amdgcn_alignbit(d[i], d[i], 16) ^ 0x80000000u;
    return __builtin_bit_cast(bf16x8, d);
}
__device__ __forceinline__ int f3swz(int R3) { return (R3 & 8) | ((R3 & 7) ^ ((R3 >> 3) & 7)); }
__device__ __forceinline__ void p2_fft(Frame& F) {
    LAS unsigned char* D = F.lds; LAS unsigned char* CM = F.lds + 131072;
    const int tid = F.tid, lane = F.lane, w = F.wave, fr = lane & 15, fq = lane >> 4;
    for (int e = tid; e < 4096; e += NTHREADS) { const int k = e >> 6, n = e & 63; float s, c; sincospif((float)((k * n) & 63) * (1.0f / 32.0f), &s, &c);
        *(LAS unsigned*)(CM + k * 256 + (((n >> 2) ^ (k & 15)) * 16) + (n & 3) * 4) = cvt_pk_bf16(c * 0.125f, s * 0.125f); }
    __syncthreads();
    for (int item = F.bx; item < 1024; item += F.G) {
        int lanev = lane; asm volatile("" : "+v"(lanev));
        const int frv = lanev & 15, fqv = lanev >> 4, tidv = w * 64 + lanev;
        const int bg = item >> 4, slab = item & 15;
        const size_t ibase = ((size_t)bg * 16 + slab) * (4096 * 16);
        const bf16_t* Zs = F.BA + ibase; const bf16_t* Gs = F.BB + ibase; bf16_t* Ys = F.BC + ibase;
        { const int half = lanev & 1, n2 = w * 8 + ((lanev >> 1) & 7), n1l = (lanev >> 4) & 3;
            u32x4 v[16];
#pragma unroll
            for (int i = 0; i < 16; ++i) { const int tok = (i * 4 + n1l) * 64 + n2; v[i] = *(const u32x4*)(Zs + tok * 16 + half * 8); }
#pragma unroll
            for (int i = 0; i < 16; ++i) { const int n1 = i * 4 + n1l;
#pragma unroll
                for (int d = 0; d < 4; ++d) { const int R1 = (half * 4 + d) * 64 + n2; *(LAS unsigned*)(D + R1 * 256 + (((n1 >> 2) ^ (R1 & 15)) * 16) + (n1 & 3) * 4) = v[i][d]; } } }
        __syncthreads();
        f32x4 aR[4][4], aI[4][4];
#pragma unroll
        for (int a = 0; a < 4; ++a)
#pragma unroll
            for (int kb = 0; kb < 4; ++kb) { aR[a][kb] = (f32x4){0.f, 0.f, 0.f, 0.f}; aI[a][kb] = (f32x4){0.f, 0.f, 0.f, 0.f}; }
#pragma unroll 1
        for (int ks = 0; ks < 4; ++ks) { const int ch = ((ks * 4 + fqv) ^ frv) * 16;
            bf16x8 Y[4], X[4];
#pragma unroll
            for (int kb = 0; kb < 4; ++kb) Y[kb] = *(const LAS bf16x8*)(CM + (kb * 16 + frv) * 256 + ch);
#pragma unroll
            for (int a = 0; a < 4; ++a) X[a] = *(const LAS bf16x8*)(D + (w * 64 + a * 16 + frv) * 256 + ch);
#pragma unroll
            for (int a = 0; a < 4; ++a) { const bf16x8 Xs = rot_negre(X[a]);
#pragma unroll
                for (int kb = 0; kb < 4; ++kb) { aR[a][kb] = __builtin_amdgcn_mfma_f32_16x16x32_bf16(X[a], Y[kb], aR[a][kb], 0, 0, 0); aI[a][kb] = __builtin_amdgcn_mfma_f32_16x16x32_bf16(Xs, Y[kb], aI[a][kb], 0, 0, 0); } } }
        __syncthreads();
#pragma unroll
        for (int a = 0; a < 4; ++a)
#pragma unroll
            for (int kb = 0; kb < 4; ++kb) { const int k1 = kb * 16 + frv, R3 = k1 * 8 + w; float o[8];
#pragma unroll
                for (int v = 0; v < 4; ++v) { const int n2 = a * 16 + fqv * 4 + v; const float ang = (float)((n2 * k1) & 4095) * (1.0f / 4096.0f);
                    const float c = __builtin_amdgcn_cosf(ang), s = __builtin_amdgcn_sinf(ang), tr = aR[a][kb][v], ti = aI[a][kb][v];
                    o[2 * v] = tr * c + ti * s; o[2 * v + 1] = ti * c - tr * s; }
                u32x4 pk; pk.x = cvt_pk_bf16(o[0], o[1]); pk.y = cvt_pk_bf16(o[2], o[3]); pk.z = cvt_pk_bf16(o[4], o[5]); pk.w = cvt_pk_bf16(o[6], o[7]);
                *(LAS u32x4*)(D + R3 * 256 + (((a * 4 + fqv) ^ f3swz(R3)) * 16)) = pk; }
        __syncthreads();
        f32x4 c3[4][4], cI[4][4];
#pragma unroll
        for (int a = 0; a < 4; ++a)
#pragma unroll
            for (int kb = 0; kb < 4; ++kb) { c3[a][kb] = (f32x4){0.f, 0.f, 0.f, 0.f}; cI[a][kb] = (f32x4){0.f, 0.f, 0.f, 0.f}; }
#pragma unroll 1
        for (int ks = 0; ks < 4; ++ks) {
            bf16x8 Y[4], X[4];
#pragma unroll
            for (int kb = 0; kb < 4; ++kb) Y[kb] = *(const LAS bf16x8*)(CM + (kb * 16 + frv) * 256 + (((ks * 4 + fqv) ^ frv) * 16));
#pragma unroll
            for (int jj = 0; jj < 4; ++jj) { const int R3 = (w * 4 + jj) * 16 + frv; X[jj] = *(const LAS bf16x8*)(D + R3 * 256 + (((ks * 4 + fqv) ^ f3swz(R3)) * 16)); }
#pragma unroll
            for (int jj = 0; jj < 4; ++jj) {
#pragma unroll
                for (int kb = 0; kb < 4; ++kb) c3[jj][kb] = __builtin_amdgcn_mfma_f32_16x16x32_bf16(X[jj], Y[kb], c3[jj][kb], 0, 0, 0);
                if (slab == 0) { const bf16x8 Xs = rot_negre(X[jj]);
#pragma unroll
                    for (int kb = 0; kb < 4; ++kb) cI[jj][kb] = __builtin_amdgcn_mfma_f32_16x16x32_bf16(Xs, Y[kb], cI[jj][kb], 0, 0, 0); } } }
        __syncthreads();
#pragma unroll
        for (int jj = 0; jj < 4; ++jj)
#pragma unroll
            for (int kb = 0; kb < 4; ++kb) { const int k1 = 2 * (w * 4 + jj) + (fqv >> 1), k2 = kb * 16 + frv, k = k1 + 64 * k2;
                u32x2 pk; pk.x = cvt_pk_bf16(c3[jj][kb][0], c3[jj][kb][1]); pk.y = cvt_pk_bf16(c3[jj][kb][2], c3[jj][kb][3]);
                *(LAS u32x2*)(D + (k + k2) * 16 + (fqv & 1) * 8) = pk;
                if (slab == 0 && (fqv & 1) == 0) *(LAS float*)(D + 98304 + k * 4) = cI[jj][kb][0]; }
        __syncthreads();
#pragma unroll 4
        for (int i = 0; i < 16; ++i) { const int q = tidv + NTHREADS * i, k = q >> 1, half = q & 1, km = (4096 - k) & 4095;
            const u32x4 a = *(const LAS u32x4*)(D + (k + (k >> 6)) * 16), bm = *(const LAS u32x4*)(D + (km + (km >> 6)) * 16);
            const u32x4 gt = *(const u32x4*)(Gs + k * 16 + half * 8);
            const u32x4 src = half ? bm : a; float vals[8];
#pragma unroll
            for (int d = 0; d < 4; ++d) { vals[2 * d] = bf_lo(src[d]); vals[2 * d + 1] = bf_hi(src[d]); }
            if (slab == 0) { if (half == 0) vals[0] = 0.5f * (bf_lo(a[0]) + bf_lo(bm[0])); else vals[0] = 0.5f * (*(const LAS float*)(D + 98304 + k * 4) + *(const LAS float*)(D + 98304 + km * 4)); }
            u32x4 o;
#pragma unroll
            for (int d = 0; d < 4; ++d) o[d] = cvt_pk_bf16(vals[2 * d] * bf_lo(gt[d]), vals[2 * d + 1] * bf_hi(gt[d]));
            *(u32x4*)(Ys + k * 16 + half * 8) = o; }
        __syncthreads();
    }
}

__device__ __forceinline__ int vswz(int row) { return (row & 15) ^ ((row >> 5) & 3); }
template <bool DUMMY> __device__ __forceinline__ void p5_sgu(Frame& F) {
    LAS unsigned char* VT = F.lds; LAS unsigned char* WS = F.lds + 65536;
    const int tid = F.tid, lane = F.lane, w = F.wave, fr = lane & 15, fq = lane >> 4;
    for (int item = F.bx; item < 2048; item += F.G) {
        int lanev = lane; asm volatile("" : "+v"(lanev));
        const int frv = lanev & 15, fqv = lanev >> 4, tidv = w * 64 + lanev;
        const int g = item & 7, n = (item >> 3) & 31, b = item >> 8, row0 = b * 4096 + n * 128, col0 = g * 256;
        u32x4 uu[8], zz[8];
#pragma unroll
        for (int jp = 0; jp < 8; ++jp) { const size_t off = (size_t)(row0 + jp * 16 + frv) * EI + col0 + w * 32 + fqv * 8; uu[jp] = *(const u32x4*)(F.BA + off); zz[jp] = *(const u32x4*)(F.BC + off); }
#pragma unroll
        for (int i = 0; i < 4; ++i) { const int idx = tidv + NTHREADS * i, p = idx >> 4, qc = idx & 15; const float* src = F.wsp + ((size_t)g * 128 + p) * 128 + qc * 8;
            const f32x4 a0 = *(const f32x4*)src, a1 = *(const f32x4*)(src + 4);
            *(LAS u32x4*)(WS + p * 256 + ((qc ^ (p & 15)) * 16)) = pack8(a0, a1); }
        { const int c8 = tidv & 31; float gam[8], bet[8];
            { const f32x4 g0 = *(const f32x4*)(F.lng + col0 + c8 * 8), g1 = *(const f32x4*)(F.lng + col0 + c8 * 8 + 4), b0 = *(const f32x4*)(F.lnb + col0 + c8 * 8), b1 = *(const f32x4*)(F.lnb + col0 + c8 * 8 + 4);
#pragma unroll
                for (int i = 0; i < 4; ++i) { gam[i] = g0[i]; gam[4 + i] = g1[i]; bet[i] = b0[i]; bet[4 + i] = b1[i]; } }
#pragma unroll
            for (int j = 0; j < 4; ++j) { const int q = 2 * ((tidv >> 5) + 16 * j), r0 = row0 + q;
                const u32x4 va = *(const u32x4*)(F.BB + (size_t)r0 * EI + col0 + c8 * 8), vb = *(const u32x4*)(F.BB + (size_t)(r0 + 1) * EI + col0 + c8 * 8);
                const float mu0 = F.vsum[r0] * (1.0f / EI), mu1 = F.vsum[r0 + 1] * (1.0f / EI);
                const float rs0 = __builtin_amdgcn_rsqf(fmaxf(F.vsq[r0] * (1.0f / EI) - mu0 * mu0, 0.f) + EPS), rs1 = __builtin_amdgcn_rsqf(fmaxf(F.vsq[r0 + 1] * (1.0f / EI) - mu1 * mu1, 0.f) + EPS);
#pragma unroll
                for (int i = 0; i < 8; ++i) { const float x0 = (i & 1) ? bf_hi(va[i >> 1]) : bf_lo(va[i >> 1]), x1 = (i & 1) ? bf_hi(vb[i >> 1]) : bf_lo(vb[i >> 1]);
                    const float y0 = (x0 - mu0) * rs0 * gam[i] + bet[i], y1 = (x1 - mu1) * rs1 * gam[i] + bet[i];
                    const int c = c8 * 8 + i, cl = c & 31, row = (c & ~31) + 16 * ((cl >> 2) & 1) + 4 * (cl >> 3) + (cl & 3);
                    *(LAS unsigned*)(VT + row * 256 + (((q >> 3) ^ vswz(row)) * 16) + (q & 7) * 2) = cvt_pk_bf16(y0, y1); } } }
        __syncthreads();
        f32x4 acc[2][8];
#pragma unroll
        for (int nn = 0; nn < 2; ++nn)
#pragma unroll
            for (int jp = 0; jp < 8; ++jp) acc[nn][jp] = (f32x4){0.f, 0.f, 0.f, 0.f};
#pragma unroll
        for (int ks = 0; ks < 4; ++ks) { bf16x8 X[2], Y[8];
#pragma unroll
            for (int nn = 0; nn < 2; ++nn) { const int row = w * 32 + nn * 16 + frv; X[nn] = *(const LAS bf16x8*)(VT + row * 256 + (((ks * 4 + fqv) ^ vswz(row)) * 16)); }
#pragma unroll
            for (int jp = 0; jp < 8; ++jp) Y[jp] = *(const LAS bf16x8*)(WS + (jp * 16 + frv) * 256 + (((ks * 4 + fqv) ^ frv) * 16));
#pragma unroll
            for (int nn = 0; nn < 2; ++nn)
#pragma unroll
                for (int jp = 0; jp < 8; ++jp) acc[nn][jp] = __builtin_amdgcn_mfma_f32_16x16x32_bf16(X[nn], Y[jp], acc[nn][jp], 0, 0, 0); }
#pragma unroll
        for (int jp = 0; jp < 8; ++jp) { const int p = jp * 16 + frv; const float bs = F.bsp[g * 128 + p]; u32x4 o;
#pragma unroll
            for (int d = 0; d < 4; ++d) { const f32x4 a = acc[d >> 1][jp]; const float m0 = a[(d & 1) * 2] + bs, m1 = a[(d & 1) * 2 + 1] + bs;
                o[d] = cvt_pk_bf16(bf_lo(uu[jp][d]) * m0 * bf_lo(zz[jp][d]), bf_hi(uu[jp][d]) * m1 * bf_hi(zz[jp][d])); }
            { const size_t oo = (size_t)(row0 + p) * EI + col0 + w * 32 + fqv * 8; if (DUMMY) *(u32x4*)(F.HB + (oo & ((size_t)MROWS * DM - 1))) = o; else *(u32x4*)(F.BA + oo) = o; } }
        __syncthreads();
    }
}

__device__ __forceinline__ void p7_final(Frame& F) {
    const int gw = F.bx * NWAVES + F.wave, NGW = F.G * NWAVES;
    const f32x4 g0 = *((const f32x4*)F.nf + 2 * F.lane), g1 = *((const f32x4*)F.nf + 2 * F.lane + 1), g2 = *((const f32x4*)F.nf + 128 + 2 * F.lane), g3 = *((const f32x4*)F.nf + 128 + 2 * F.lane + 1);
    for (int m0 = gw * 2; m0 < MROWS; m0 += NGW * 2) {
        u32x4 a[2], b[2]; float rstd[2];
#pragma unroll
        for (int r = 0; r < 2; ++r) { const u32x4* xr = (const u32x4*)(F.HB + (size_t)(m0 + r) * DM); a[r] = xr[F.lane]; b[r] = xr[64 + F.lane]; rstd[r] = __builtin_amdgcn_rsqf(F.ss2[m0 + r] * (1.0f / DM) + EPS); }
#pragma unroll
        for (int r = 0; r < 2; ++r) { f32x4* o = (f32x4*)(F.out + (size_t)(m0 + r) * DM); const float rs = rstd[r];
            o[2 * F.lane]           = (f32x4){bf_lo(a[r].x), bf_hi(a[r].x), bf_lo(a[r].y), bf_hi(a[r].y)} * g0 * rs;
            o[2 * F.lane + 1]       = (f32x4){bf_lo(a[r].z), bf_hi(a[r].z), bf_lo(a[r].w), bf_hi(a[r].w)} * g1 * rs;
            o[128 + 2 * F.lane]     = (f32x4){bf_lo(b[r].x), bf_hi(b[r].x), bf_lo(b[r].y), bf_hi(b[r].y)} * g2 * rs;
            o[128 + 2 * F.lane + 1] = (f32x4){bf_lo(b[r].z), bf_hi(b[r].z), bf_lo(b[r].w), bf_hi(b[r].w)} * g3 * rs; }
    }
}

__global__ void __launch_bounds__(NTHREADS, 2) fwd_megakernel(Args args) {
    extern __shared__ __attribute__((aligned(16))) unsigned char lds_raw[];
    cg::grid_group grid = cg::this_grid();
    Frame F;
    F.lds = (LAS unsigned char*)lds_raw; F.tid = threadIdx.x; F.lane = F.tid & 63; F.wave = __builtin_amdgcn_readfirstlane(F.tid >> 6); F.G = gridDim.x; F.bx = blockIdx.x;
    F.x = args.in[0]; F.n0 = args.in[1]; F.win0 = args.in[2]; F.wout0 = args.in[3]; F.n1 = args.in[4]; F.win1 = args.in[5]; F.lng = args.in[6]; F.lnb = args.in[7];
    F.wsp = args.in[8]; F.bsp = args.in[9]; F.wout1 = args.in[10]; F.nf = args.in[11]; F.out = args.out;
    unsigned char* ws = args.ws;
    F.ss1 = (float*)(ws + WS_SS1); F.vsum = (float*)(ws + WS_VSUM); F.vsq = (float*)(ws + WS_VSQ); F.ss2 = (float*)(ws + WS_SS2);
    F.W0t = (bf16_t*)(ws + WS_W0T); F.Wo0t = (bf16_t*)(ws + WS_WO0T); F.W1t = (bf16_t*)(ws + WS_W1T); F.Wo1t = (bf16_t*)(ws + WS_WO1T);
    F.HB = (bf16_t*)(ws + WS_HB); F.BA = (bf16_t*)(ws + WS_BUFA); F.BB = (bf16_t*)(ws + WS_BUFB); F.BC = (bf16_t*)(ws + WS_BUFC);

    volatile LAS unsigned* MISC = (volatile LAS unsigned*)(F.lds + MISC_OFF);
    if (F.tid < 32) MISC[F.tid] = 0u;
    __syncthreads();
#ifdef PROBE_A
    unsigned long long ts[9]; int nts = 0;
#define STAMP() do { ts[nts++] = __builtin_amdgcn_s_memrealtime(); } while (0)
#else
#define STAMP() do { } while (0)
#endif
    XcdBarrier bar = xcd_barrier_post((unsigned*)(ws + WS_BAR), MISC);
    if (ws == nullptr) grid.sync();
    STAMP();
    p0_prep(F);
#if defined(DUP) && (DUP & 1)
    p0_prep(F);
#endif
    xcd_barrier(bar); STAMP();
    { pg8::Gemm g{F.HB, F.W0t, MROWS, 4096, DM}; pg8::StaticOrder S; S.init(MROWS, 4096, F.G, F.bx); Epi1 E{F.BA, F.BB};
      pg8::gemm_phase<Epi1, false>(F.lds, g, S, E);
#if defined(DUP) && (DUP & 2)
      __syncthreads(); pg8::gemm_phase<Epi1, false>(F.lds, g, S, E);
#endif
    }
    xcd_barrier(bar); STAMP();
    p2_fft(F);
#if defined(DUP) && (DUP & 4)
    p2_fft(F);
#endif
    xcd_barrier(bar); STAMP();
    { pg8::Gemm g{F.BC, F.Wo0t, MROWS, DM, EI}; pg8::StaticOrder S; S.init(MROWS, DM, F.G, F.bx); EpiRes<true> E{F.x, F.HB, F.ss1};
#if defined(DUP) && (DUP & 8)
      { EpiRes<true> E2{F.x, F.HB, (float*)(ws + 640 * 1024)}; pg8::gemm_phase<EpiRes<true>, true>(F.lds, g, S, E2); __syncthreads(); }
#endif
      pg8::gemm_phase<EpiRes<true>, true>(F.lds, g, S, E); }
    xcd_barrier(bar); STAMP();
    { pg8::Gemm g{F.HB, F.W1t, MROWS, 6144, DM}; pg8::StaticOrder S; S.init(MROWS, 6144, F.G, F.bx); Epi3 E{F.ss1, F.BA, F.vsum, F.vsq};
#if defined(DUP) && (DUP & 16)
      { Epi3 E2{F.ss1, F.BA, (float*)(ws + 640 * 1024), (float*)(ws + 768 * 1024)}; pg8::gemm_phase<Epi3, false>(F.lds, g, S, E2); __syncthreads(); }
#endif
      pg8::gemm_phase<Epi3, false>(F.lds, g, S, E); }
    xcd_barrier(bar); STAMP();
#if defined(DUP) && (DUP & 32)
    p5_sgu<true>(F);
#endif
    p5_sgu<false>(F);
    xcd_barrier(bar); STAMP();
    { pg8::Gemm g{F.BA, F.Wo1t, MROWS, DM, EI}; pg8::StaticOrder S; S.init(MROWS, DM, F.G, F.bx); EpiRes<false> E{nullptr, F.HB, F.ss2};
      pg8::gemm_phase<EpiRes<false>, false>(F.lds, g, S, E); }
    xcd_barrier(bar); STAMP();
    p7_final(F);
#ifdef PROBE_A
    xcd_barrier(bar); STAMP();
    if (F.bx == 0) { const float ta = (float)(ts[PROBE_A + 1] - ts[PROBE_A]) * 0.01f, tb = (float)(ts[PROBE_B + 1] - ts[PROBE_B]) * 0.0001f;
        for (int i = 1 + F.tid; i < MROWS * DM / 16; i += NTHREADS) F.out[i] += tb;
        if (F.tid == 0) F.out[0] = ta; }
#endif
}

extern "C" void kernel_launch(void* const* d_in, const int* in_sizes, int n_in, void* d_out, int out_size, void* d_ws, size_t ws_size, hipStream_t stream) {
    static int grid = 0;
    if (!grid) {
        if (n_in != 12 || in_sizes[0] != MROWS * DM || out_size != MROWS * DM || ws_size < WS_END) {
            fprintf(stderr, "kernel_launch: unexpected problem (n_in %d, in0 %d, out %d, ws %zu); nothing launched\n", n_in, in_sizes[0], out_size, ws_size); grid = -1; return; }
        int dev = 0, cus = 0, per_cu = 0;
        if (hipGetDevice(&dev) != hipSuccess || hipDeviceGetAttribute(&cus, hipDeviceAttributeMultiprocessorCount, dev) != hipSuccess) { grid = -1; return; }
        if (hipFuncSetAttribute((const void*)fwd_megakernel, hipFuncAttributeMaxDynamicSharedMemorySize, LDS_BYTES) != hipSuccess) { fprintf(stderr, "kernel_launch: hipFuncSetAttribute failed\n"); grid = -1; return; }
        if (hipOccupancyMaxActiveBlocksPerMultiprocessor(&per_cu, (const void*)fwd_megakernel, NTHREADS, LDS_BYTES) != hipSuccess || per_cu < 1) per_cu = 1;
        grid = cus * per_cu;
    }
    if (grid < 0) return;
    if (hipMemsetAsync((char*)d_ws + WS_BAR, 0, XCD_BAR_WORDS * 4, stream) != hipSuccess) { fprintf(stderr, "kernel_launch: hipMemsetAsync failed\n"); return; }
    Args a{};
    for (int i = 0; i < 12; ++i) a.in[i] = (const float*)d_in[i];
    a.out = (float*)d_out; a.ws = (unsigned char*)d_ws;
    void* kargs[] = {&a};
    hipError_t e = hipLaunchCooperativeKernel((const void*)fwd_megakernel, dim3(grid), dim3(NTHREADS), kargs, LDS_BYTES, stream);
    if (e != hipSuccess) fprintf(stderr, "kernel_launch: cooperative launch failed: %s (grid %d)\n", hipGetErrorString(e), grid);
}
```

```cpp
#include <hip/hip_runtime.h>
#include <hip/hip_cooperative_groups.h>
#include <cstdio>
#include <cstdint>
namespace cg = cooperative_groups;

#define LAS __attribute__((address_space(3)))
typedef unsigned short bf16_t;
typedef short bf16x8 __attribute__((ext_vector_type(8)));
typedef float f32x4 __attribute__((ext_vector_type(4)));
typedef float f32x2 __attribute__((ext_vector_type(2)));
typedef unsigned u32x4 __attribute__((ext_vector_type(4)));
typedef unsigned u32x2 __attribute__((ext_vector_type(2)));

constexpr int MROWS = 32768, DM = 1024, EI = 2048, SEQ = 4096;
constexpr float EPS = 1e-6f;
constexpr int NTHREADS = 512, NWAVES = 8;
constexpr int LDS_BYTES = 148480;
constexpr size_t MiB = 1u << 20;
constexpr size_t WS_SS1 = 0, WS_VSUM = 128 * 1024, WS_VSQ = 256 * 1024, WS_SS2 = 384 * 1024, WS_BAR = 512 * 1024;
constexpr int MISC_OFF = 147456;
constexpr size_t WS_W0T = 1 * MiB, WS_WO0T = 9 * MiB, WS_W1T = 13 * MiB, WS_WO1T = 25 * MiB;
constexpr size_t WS_HB = 32 * MiB, WS_BUFA = 96 * MiB, WS_BUFB = 224 * MiB, WS_BUFC = 352 * MiB, WS_END = 480 * MiB;

__device__ __forceinline__ unsigned cvt_pk_bf16(float lo, float hi) { unsigned r; asm volatile("v_cvt_pk_bf16_f32 %0, %1, %2" : "=v"(r) : "v"(lo), "v"(hi)); return r; }
__device__ __forceinline__ float bf_lo(unsigned u) { return __uint_as_float(u << 16); }
__device__ __forceinline__ float bf_hi(unsigned u) { return __uint_as_float(u & 0xffff0000u); }
__device__ __forceinline__ float silu_f(float x) { return x * __builtin_amdgcn_rcpf(1.0f + __builtin_amdgcn_exp2f(-1.4426950409f * x)); }
__device__ __forceinline__ float gelu_f(float x) { const float t = x * (1.0f + 0.044715f * x * x); return x * __builtin_amdgcn_rcpf(1.0f + __builtin_amdgcn_exp2f(-2.302208198f * t)); }
__device__ __forceinline__ float wave_sum(float v) {
#pragma unroll
    for (int o = 1; o < 64; o <<= 1) v += __shfl_xor(v, o);
    return v;
}
__host__ __device__ __forceinline__ int chan_of_pos(int p) { const int s = p >> 4, e = p & 15; if (e < 8) return 8 * s + e; const int j = 8 * s + (e - 8); return j == 0 ? 128 : 256 - j; }
__host__ __device__ __forceinline__ int pos_of_chan(int ch) { if (ch < 128) return 16 * (ch >> 3) + (ch & 7); if (ch == 128) return 8; const int j = 256 - ch; return 16 * (j >> 3) + 8 + (j & 7); }

namespace pg8 {
constexpr int BM = 256, BK = 64, HALF = 128, HTB = HALF * BK * 2, STAGE_BYTES = 8 * HTB, NXCD = 8, WGM = 8;
__host__ __device__ __forceinline__ int lds_byte(int r, int c) { const int st = (r >> 4) * 2 + (c >> 5), rr = r & 15, cc = c & 31, ob = rr * 64 + cc * 2; return st * 1024 + (ob ^ (((ob >> 9) & 1) << 5)); }
__host__ __device__ __forceinline__ void stage_rc(int b, int& R, int& C) { const int st = b / 1024, sb = b % 1024, swz = sb ^ (((sb >> 9) & 1) << 5); R = (st >> 1) * 16 + swz / 64; C = (st & 1) * 32 + (swz % 64) / 2; }
__host__ __device__ __forceinline__ int perm32(int rho) { const int n = rho >> 4, i = rho & 15; return 8 * (i >> 2) + 4 * n + (i & 3); }
struct Unit { int pm, pn; };
struct Gemm { const bf16_t* A; const bf16_t* Bt; int M, N, K; };
struct StaticOrder {
    int nM, nN, nwg, G, c;
    __host__ __device__ void init(int M, int N, int G_, int c_) { nM = M / BM; nN = N / BM; nwg = nM * nN; G = G_; c = c_; }
    __host__ __device__ bool next(int i, Unit& u) const {
        const long L = (long)i * G + c; if (L >= nwg) return false;
        int wgid = (int)L; { const int q = nwg / NXCD, r = nwg % NXCD, xcd = wgid % NXCD, off = wgid / NXCD; wgid = (xcd < r ? xcd * (q + 1) : r * (q + 1) + (xcd - r) * q) + off; }
        const int nig = WGM * nN, gid = wgid / nig, fm = gid * WGM, gsz = (nM - fm) < WGM ? (nM - fm) : WGM;
        u.pm = fm + ((wgid % nig) % gsz); u.pn = (wgid % nig) / gsz; return true;
    }
};
template <class Epi, bool ABLK>
__device__ __forceinline__ void gemm_phase(LAS unsigned char* lds, const Gemm g, const StaticOrder& S, const Epi& E) {
    const int tid = threadIdx.x, wid = __builtin_amdgcn_readfirstlane(tid >> 6), lane = tid & 63, wr = wid >> 2, wc = wid & 3, fr = lane & 15, fq = lane >> 4;
    const int K = g.K, nt = K / BK;
    unsigned voffA[2], voffB[2];
#pragma unroll
    for (int i = 0; i < 2; ++i) { int R, C; stage_rc(tid * 16 + i * 8192, R, C); const int Rb = (R & ~31) + perm32(R & 31);
        voffA[i] = ABLK ? (unsigned)((C >> 4) * 65536 + R * 16 + (C & 15)) * 2u : (unsigned)(R * K + C) * 2u; voffB[i] = (unsigned)(Rb * K + C) * 2u; }
    const size_t kstepB = (size_t)(BK * 2), hstepB = (size_t)HALF * K * 2, tstepB = 2 * hstepB;
    const size_t kstepA = ABLK ? (size_t)4 * 65536 * 2 : kstepB, hstepA = ABLK ? (size_t)HALF * 16 * 2 : hstepB;
#define PG8_ABASE(pm) ((const char*)g.A + (ABLK ? ((size_t)((pm) >> 4) * 4096 * 2048 + (size_t)((pm) & 15) * 256 * 16) * 2 : (size_t)(pm) * tstepB))
    const unsigned ldsw = (unsigned)wid * 1024u;
    const int aoff = lds_byte(wr * 64 + fr, fq * 8), boff = lds_byte(wc * 32 + fr, fq * 8);
#define PG8_SA(b, h) (((b) * 2 + (h)) * HTB)
#define PG8_SB(b, h) ((4 + (b) * 2 + (h)) * HTB)
#define PG8_STAGE(bufoff, gbase, voff) do { _Pragma("unroll") for (int _i = 0; _i < 2; ++_i) \
        __builtin_amdgcn_global_load_lds((const unsigned*)((const char*)(gbase) + (voff)[_i]), (LAS unsigned*)(lds + (bufoff) + ldsw + _i * 8192), 16, 0, 0); } while (0)
#define PG8_LDA(dst, b, h) do { _Pragma("unroll") for (int m = 0; m < 4; ++m) _Pragma("unroll") for (int k = 0; k < 2; ++k) dst[m][k] = *(const LAS bf16x8*)(lds + PG8_SA(b, h) + aoff + m * 2048 + k * 1024); } while (0)
#define PG8_LDB(dst, b, h) do { _Pragma("unroll") for (int n = 0; n < 2; ++n) _Pragma("unroll") for (int k = 0; k < 2; ++k) dst[n][k] = *(const LAS bf16x8*)(lds + PG8_SB(b, h) + boff + n * 2048 + k * 1024); } while (0)
#define PG8_MMA(ai, bj, At, Bt) do { __builtin_amdgcn_s_setprio(1); _Pragma("unroll") for (int m = 0; m < 4; ++m) _Pragma("unroll") for (int n = 0; n < 2; ++n) _Pragma("unroll") for (int k = 0; k < 2; ++k) \
        acc[ai][bj][m][n] = __builtin_amdgcn_mfma_f32_16x16x32_bf16(Bt[n][k], At[m][k], acc[ai][bj][m][n], 0, 0, 0); __builtin_amdgcn_s_setprio(0); } while (0)
#define PG8_WAIT_V(n) asm volatile("s_waitcnt vmcnt(" #n ")" ::: "memory")
#define PG8_WAIT_L(n) asm volatile("s_waitcnt lgkmcnt(" #n ")" ::: "memory")
#define PG8_BAR __builtin_amdgcn_s_barrier()
#define PG8_SCHED __builtin_amdgcn_sched_barrier(0)
    Unit cur, nxt; int ui = 0;
    if (!S.next(0, cur)) return;
    f32x4 acc[2][2][4][2];
#pragma unroll
    for (int a = 0; a < 2; ++a)
#pragma unroll
        for (int b = 0; b < 2; ++b)
#pragma unroll
            for (int m = 0; m < 4; ++m)
#pragma unroll
                for (int n = 0; n < 2; ++n) acc[a][b][m][n] = (f32x4){0.f, 0.f, 0.f, 0.f};
    bf16x8 At[4][2], B0[2][2], B1[2][2];
    const char* cA = PG8_ABASE(cur.pm); const char* cB = (const char*)g.Bt + (size_t)cur.pn * tstepB;
    PG8_STAGE(PG8_SB(0, 0), cB, voffB); PG8_STAGE(PG8_SB(0, 1), cB + hstepB, voffB); PG8_STAGE(PG8_SA(0, 0), cA, voffA); PG8_STAGE(PG8_SA(0, 1), cA + hstepA, voffA);
    if (wr == 1) PG8_BAR;
    PG8_WAIT_V(2); PG8_BAR;
    PG8_STAGE(PG8_SB(1, 0), cB + kstepB, voffB); PG8_STAGE(PG8_SA(1, 0), cA + kstepA, voffA); PG8_STAGE(PG8_SB(1, 1), cB + hstepB + kstepB, voffB);
    PG8_WAIT_V(6); PG8_BAR;
    for (;;) {
        const bool has_next = S.next(ui + 1, nxt);
        const char* nA = has_next ? PG8_ABASE(nxt.pm) : cA; const char* nB = has_next ? (const char*)g.Bt + (size_t)nxt.pn * tstepB : cB;
        for (int t = 0; t < nt; t += 2) {
            const bool last = (t == nt - 2);
            const char* a1 = cA + (size_t)(t + 1) * kstepA;
            const char* a2 = last ? nA : cA + (size_t)(t + 2) * kstepA; const char* b2 = last ? nB : cB + (size_t)(t + 2) * kstepB;
            const char* a3 = a2 + kstepA; const char* b3 = b2 + kstepB;
            PG8_LDB(B0, 0, 0); PG8_LDB(B1, 0, 1); PG8_SCHED; PG8_LDA(At, 0, 0); PG8_STAGE(PG8_SA(1, 1), a1 + hstepA, voffA);
            PG8_WAIT_V(8); PG8_WAIT_L(0); PG8_BAR; PG8_MMA(0, 0, At, B0); PG8_MMA(0, 1, At, B1); PG8_BAR; PG8_SCHED;
            PG8_LDA(At, 0, 1); PG8_STAGE(PG8_SB(0, 0), b2, voffB); PG8_STAGE(PG8_SB(0, 1), b2 + hstepB, voffB); PG8_STAGE(PG8_SA(0, 0), a2, voffA);
            PG8_WAIT_V(8); PG8_WAIT_L(0); PG8_BAR; PG8_MMA(1, 0, At, B0); PG8_MMA(1, 1, At, B1); PG8_BAR; PG8_SCHED;
            PG8_LDB(B0, 1, 0); PG8_LDB(B1, 1, 1); PG8_SCHED; PG8_LDA(At, 1, 0); PG8_STAGE(PG8_SA(0, 1), a2 + hstepA, voffA);
            PG8_WAIT_V(8); PG8_WAIT_L(0); PG8_BAR; PG8_MMA(0, 0, At, B0); PG8_MMA(0, 1, At, B1); PG8_BAR; PG8_SCHED;
            PG8_LDA(At, 1, 1); PG8_STAGE(PG8_SB(1, 0), b3, voffB); PG8_STAGE(PG8_SB(1, 1), b3 + hstepB, voffB); PG8_STAGE(PG8_SA(1, 0), a3, voffA);
            PG8_WAIT_V(8); PG8_WAIT_L(0); PG8_BAR; PG8_MMA(1, 0, At, B0); PG8_MMA(1, 1, At, B1); PG8_BAR; PG8_SCHED;
        }
        if (wr == 0) PG8_BAR;
        E(acc, cur, wr, wc, fr, fq);
        if (!has_next) break;
#pragma unroll
        for (int a = 0; a < 2; ++a)
#pragma unroll
            for (int b = 0; b < 2; ++b)
#pragma unroll
                for (int m = 0; m < 4; ++m)
#pragma unroll
                    for (int n = 0; n < 2; ++n) acc[a][b][m][n] = (f32x4){0.f, 0.f, 0.f, 0.f};
        cur = nxt; cA = nA; cB = nB; ++ui;
        if (wr == 1) PG8_BAR;
    }
    PG8_WAIT_V(0);
    PG8_BAR;
#undef PG8_ABASE
#undef PG8_SA
#undef PG8_SB
#undef PG8_STAGE
#undef PG8_LDA
#undef PG8_LDB
#undef PG8_MMA
#undef PG8_WAIT_V
#undef PG8_WAIT_L
#undef PG8_BAR
#undef PG8_SCHED
}
}

__device__ __forceinline__ u32x4 pack8(const f32x4 v0, const f32x4 v1) { u32x4 w; w.x = cvt_pk_bf16(v0[0], v0[1]); w.y = cvt_pk_bf16(v0[2], v0[3]); w.z = cvt_pk_bf16(v1[0], v1[1]); w.w = cvt_pk_bf16(v1[2], v1[3]); return w; }

struct Epi1 {
    bf16_t* Z; bf16_t* SZ;
    __device__ __forceinline__ void operator()(const f32x4 (&acc)[2][2][4][2], const pg8::Unit& u, int wr, int wc, int fr, int fq) const {
        const int b = u.pm >> 4, t0 = (u.pm & 15) * 256 + wr * 64 + fr; const bool gate = u.pn >= 8; const int g = u.pn & 7;
        bf16_t* base = (gate ? SZ : Z) + (size_t)(b * 8 + g) * (16 * 4096 * 16);
#pragma unroll
        for (int ai = 0; ai < 2; ++ai)
#pragma unroll
            for (int m = 0; m < 4; ++m) { const int t = t0 + ai * 128 + m * 16;
#pragma unroll
                for (int bj = 0; bj < 2; ++bj) { const int cgp = bj * 128 + wc * 32 + fq * 8, s = cgp >> 4, e0 = cgp & 8;
                    f32x4 v0 = acc[ai][bj][m][0], v1 = acc[ai][bj][m][1];
                    if (gate) {
#pragma unroll
                        for (int j = 0; j < 4; ++j) { v0[j] = silu_f(v0[j]); v1[j] = silu_f(v1[j]); } }
                    *(u32x4*)(base + ((size_t)s * 4096 + t) * 16 + e0) = pack8(v0, v1); } }
    }
};
template <bool FIRST> struct EpiRes {
    const float* XIN; bf16_t* XB; float* SS;
    __device__ __forceinline__ void operator()(const f32x4 (&acc)[2][2][4][2], const pg8::Unit& u, int wr, int wc, int fr, int fq) const {
        const int row0 = u.pm * 256 + wr * 64 + fr, col0 = u.pn * 256 + wc * 32 + fq * 8;
#pragma unroll
        for (int ai = 0; ai < 2; ++ai)
#pragma unroll
            for (int m = 0; m < 4; ++m) { const int row = row0 + ai * 128 + m * 16; float ss = 0.f;
#pragma unroll
                for (int bj = 0; bj < 2; ++bj) { const size_t off = (size_t)row * DM + col0 + bj * 128; f32x4 x0, x1;
                    if (FIRST) { x0 = *(const f32x4*)(XIN + off); x1 = *(const f32x4*)(XIN + off + 4); }
                    else { const u32x4 r = *(const u32x4*)(XB + off); x0 = (f32x4){bf_lo(r.x), bf_hi(r.x), bf_lo(r.y), bf_hi(r.y)}; x1 = (f32x4){bf_lo(r.z), bf_hi(r.z), bf_lo(r.w), bf_hi(r.w)}; }
                    const f32x4 v0 = acc[ai][bj][m][0] + x0, v1 = acc[ai][bj][m][1] + x1;
                    *(u32x4*)(XB + off) = pack8(v0, v1);
                    ss += (v0[0] * v0[0] + v0[1] * v0[1]) + (v0[2] * v0[2] + v0[3] * v0[3]) + (v1[0] * v1[0] + v1[1] * v1[1]) + (v1[2] * v1[2] + v1[3] * v1[3]); }
                ss += __shfl_xor(ss, 16); ss += __shfl_xor(ss, 32);
                if (fq == 0) atomicAdd(SS + row, ss); }
    }
};
struct Epi3 {
    const float* SS1; bf16_t* U; float* VSUM; float* VSQ;
    __device__ __forceinline__ void operator()(const f32x4 (&acc)[2][2][4][2], const pg8::Unit& u, int wr, int wc, int fr, int fq) const {
        const int row0 = u.pm * 256 + wr * 64 + fr, which = u.pn >> 3, col0 = (u.pn & 7) * 256 + wc * 32 + fq * 8;
        bf16_t* dst = U + (size_t)which * ((WS_BUFB - WS_BUFA) / 2);
#pragma unroll
        for (int ai = 0; ai < 2; ++ai)
#pragma unroll
            for (int m = 0; m < 4; ++m) { const int row = row0 + ai * 128 + m * 16;
                const float rs = __builtin_amdgcn_rsqf(SS1[row] * (1.0f / DM) + EPS); float s1 = 0.f, s2 = 0.f;
#pragma unroll
                for (int bj = 0; bj < 2; ++bj) { f32x4 v0 = acc[ai][bj][m][0] * rs, v1 = acc[ai][bj][m][1] * rs;
                    if (which == 2) {
#pragma unroll
                        for (int j = 0; j < 4; ++j) { v0[j] = silu_f(v0[j]); v1[j] = silu_f(v1[j]); } }
                    else {
#pragma unroll
                        for (int j = 0; j < 4; ++j) { v0[j] = gelu_f(v0[j]); v1[j] = gelu_f(v1[j]); } }
                    if (which == 1) { s1 += (v0[0] + v0[1]) + (v0[2] + v0[3]) + (v1[0] + v1[1]) + (v1[2] + v1[3]);
                        s2 += (v0[0] * v0[0] + v0[1] * v0[1]) + (v0[2] * v0[2] + v0[3] * v0[3]) + (v1[0] * v1[0] + v1[1] * v1[1]) + (v1[2] * v1[2] + v1[3] * v1[3]); }
                    *(u32x4*)(dst + (size_t)row * EI + col0 + bj * 128) = pack8(v0, v1); }
                if (which == 1) { s1 += __shfl_xor(s1, 16); s1 += __shfl_xor(s1, 32); s2 += __shfl_xor(s2, 16); s2 += __shfl_xor(s2, 32);
                    if (fq == 0) { atomicAdd(VSUM + row, s1); atomicAdd(VSQ + row, s2); } } }
    }
};


#define XB_TMO      128
#define XB_XCNT(j)  (256  + 64 * (j))
#define XB_XSUB(j)  (1280 + 64 * (j))
#define XB_XGEN(j)  (2304 + 64 * (j))
#define XB_TOP      3328
#define XB_TOPGEN   3392
#define XCD_BAR_WORDS 3456
#define XB_SPIN_CAP (1u << 18)
__device__ __forceinline__ unsigned xb_ld(unsigned* p)              { return __hip_atomic_load(p, __ATOMIC_RELAXED, __HIP_MEMORY_SCOPE_AGENT); }
__device__ __forceinline__ unsigned xb_add(unsigned* p, unsigned v) { return __hip_atomic_fetch_add(p, v, __ATOMIC_RELAXED, __HIP_MEMORY_SCOPE_AGENT); }
__device__ __forceinline__ unsigned xb_xcc_id() { return (unsigned)__builtin_amdgcn_s_getreg((3 << 11) | 20) & 0xFu; }
#define XB_SPIN(cond, bar) do { unsigned _sp = 0; while (cond) { __builtin_amdgcn_s_sleep(1); \
    if ((++_sp & 255u) == 0u) { if (xb_ld(&(bar)[XB_TMO])) break; if (_sp > XB_SPIN_CAP) { atomicAdd(&(bar)[XB_TMO], 1u); break; } } } } while (0)
struct XcdBarrier { unsigned* bar; unsigned x; volatile LAS unsigned* st; };
__device__ __forceinline__ XcdBarrier xcd_barrier_post(unsigned* bar, volatile LAS unsigned* st) {
    XcdBarrier b; b.bar = bar; b.x = xb_xcc_id(); b.st = st;
    if (threadIdx.x == 0) (void)xb_add(&bar[XB_XCNT(b.x)], 1u);
    return b;
}
__device__ __forceinline__ void xcd_barrier_complete(unsigned* bar, unsigned x, unsigned& nloc, unsigned& nx) {
    const unsigned G = gridDim.x * gridDim.y * gridDim.z;
    unsigned sum, cnt, mine, sp = 0u;
    for (;;) {
        sum = 0u; cnt = 0u; mine = 0u;
#pragma unroll
        for (unsigned j = 0; j < 16; ++j) { const unsigned c = xb_ld(&bar[XB_XCNT(j)]); sum += c; cnt += (c > 0u) ? 1u : 0u; mine = (j == x) ? c : mine; }
        if (sum == G) break;
        __builtin_amdgcn_s_sleep(1);
        if ((++sp & 255u) == 0u) { if (xb_ld(&bar[XB_TMO])) break; if (sp > XB_SPIN_CAP) { atomicAdd(&bar[XB_TMO], 1u); break; } }
    }
    nloc = mine > 0u ? mine : 1u; nx = cnt > 0u ? cnt : 1u;
}
__device__ __forceinline__ void xcd_barrier(const XcdBarrier& b) {
    asm volatile("s_waitcnt vmcnt(0)" ::: "memory");
    __syncthreads();
    if (threadIdx.x == 0) {
        unsigned* bar = b.bar;
        __builtin_amdgcn_s_waitcnt(0);
        unsigned nloc = b.st[0], nx = b.st[1];
        if (nloc == 0u) { xcd_barrier_complete(bar, b.x, nloc, nx); b.st[0] = nloc; b.st[1] = nx; }
        const unsigned old = xb_add(&bar[XB_XSUB(b.x)], 1u);
        const unsigned gen = old / nloc;
        if (old + 1u == (gen + 1u) * nloc) {
            __builtin_amdgcn_fence(__ATOMIC_RELEASE, "agent");
            asm volatile("s_waitcnt vmcnt(0)" ::: "memory");
            const unsigned og = xb_add(&bar[XB_TOP], 1u);
            const unsigned tg = og / nx;
            if (og + 1u == (tg + 1u) * nx) xb_add(&bar[XB_TOPGEN], 1u);
            else XB_SPIN(xb_ld(&bar[XB_TOPGEN]) == tg, bar);
            __builtin_amdgcn_fence(__ATOMIC_ACQUIRE, "agent");
            xb_add(&bar[XB_XGEN(b.x)], 1u);
            asm volatile("s_waitcnt vmcnt(0)" ::: "memory");
        } else {
            XB_SPIN(xb_ld(&bar[XB_XGEN(b.x)]) == gen, bar);
            __builtin_amdgcn_fence(__ATOMIC_ACQUIRE, "agent");
            asm volatile("s_waitcnt vmcnt(0)" ::: "memory");
        }
    }
    __syncthreads();
}

struct Args { const float* in[12]; float* out; unsigned char* ws; };
struct Frame {
    LAS unsigned char* lds; int tid, lane, wave, G, bx;
    const float *x, *n0, *win0, *wout0, *n1, *win1, *lng, *lnb, *wsp, *bsp, *wout1, *nf; float* out;
    float *ss1, *vsum, *vsq, *ss2;
    bf16_t *W0t, *Wo0t, *W1t, *Wo1t, *HB, *BA, *BB, *BC;
};

__device__ __forceinline__ void p0_transpose_item(const float* W, int N, bf16_t* WT, int Kd, LAS float* scr, int k0, int n0, int lane, int mode, const float* kscale) {
#pragma unroll
    for (int i = 0; i < 32; ++i) { const int kk = 2 * i + (lane >> 5), k = k0 + kk; const int sr = (mode == 2) ? ((k & ~255) + chan_of_pos(k & 255)) : k;
        float v = W[(size_t)sr * N + n0 + (lane & 31)]; if (mode == 3) v *= kscale[k]; scr[kk * 33 + (lane & 31)] = v; }
    asm volatile("s_waitcnt lgkmcnt(0)" ::: "memory");
    const int c = lane & 7;
#pragma unroll
    for (int j = 0; j < 4; ++j) { const int n = (lane >> 3) + 8 * j; const LAS float* s = scr + (8 * c) * 33 + n; const int ns = n0 + n;
        const int dr = (mode == 1) ? (2048 + (ns & 0x700) + pos_of_chan(ns & 255)) : ns;
        u32x4 o; o.x = cvt_pk_bf16(s[0 * 33], s[1 * 33]); o.y = cvt_pk_bf16(s[2 * 33], s[3 * 33]); o.z = cvt_pk_bf16(s[4 * 33], s[5 * 33]); o.w = cvt_pk_bf16(s[6 * 33], s[7 * 33]);
        *(u32x4*)(WT + (size_t)dr * Kd + k0 + 8 * c) = o; }
    asm volatile("s_waitcnt lgkmcnt(0)" ::: "memory");
}
__device__ __forceinline__ void p0_prep(Frame& F) {
    LAS float* scr = (LAS float*)(F.lds + F.wave * 16384);
    LAS float* costab = (LAS float*)(F.lds + 131072);
    if (F.tid < 256) costab[F.tid] = cospif((float)F.tid * (1.0f / 128.0f)) * (1.0f / 16.0f);
    __syncthreads();
    const int gw = F.bx * NWAVES + F.wave, NGW = F.G * NWAVES;
    for (int i = F.bx * NTHREADS + F.tid; i < 4 * MROWS; i += F.G * NTHREADS) F.ss1[i] = 0.f;
    constexpr int I_A = 16 * 64, I_B = 32 * 32, I_C = 16 * 192, I_D = 32 * 32;
    for (int it = gw; it < I_A + I_B + I_C + I_D; it += NGW) {
        int r = it;
        if (r < I_A) { const int kb = r >> 6, nb = r & 63; p0_transpose_item(F.win0, 4096, F.W0t, 1024, scr, kb * 64, 2048 + nb * 32, F.lane, 1, nullptr); continue; } r -= I_A;
        if (r < I_B) { const int kb = r >> 5, nb = r & 31; p0_transpose_item(F.wout0, 1024, F.Wo0t, 2048, scr, kb * 64, nb * 32, F.lane, 2, nullptr); continue; } r -= I_B;
        if (r < I_C) { const int kb = r / 192, nb = r % 192; p0_transpose_item(F.win1, 6144, F.W1t, 1024, scr, kb * 64, nb * 32, F.lane, 3, F.n1); continue; } r -= I_C;
        { const int kb = r >> 5, nb = r & 31; p0_transpose_item(F.wout1, 1024, F.Wo1t, 2048, scr, kb * 64, nb * 32, F.lane, 0, nullptr); }
    }
    for (int task = gw; task < 4096; task += NGW) {
        const int kb = task >> 5, g = (task >> 2) & 7, pc = task & 3, P = pc * 64 + F.lane;
        const int jeff = (P == 1) ? 128 : (P >> 1), phase = (P >= 3 && (P & 1)) ? 64 : 0;
        const float* wp = F.win0 + (size_t)(kb * 8) * 4096 + g * 256;
#pragma unroll
        for (int i = 0; i < 8; ++i) *(LAS f32x4*)(scr + i * 256 + F.lane * 4) = *(const f32x4*)(wp + (size_t)i * 4096 + F.lane * 4);
        asm volatile("s_waitcnt vmcnt(0) lgkmcnt(0)" ::: "memory");
        float a[8];
#pragma unroll
        for (int i = 0; i < 8; ++i) a[i] = 0.f;
        for (int c = 0; c < 256; c += 4) {
            float t[4];
#pragma unroll
            for (int j = 0; j < 4; ++j) t[j] = costab[(jeff * (c + j) + phase) & 255];
#pragma unroll
            for (int i = 0; i < 8; ++i) { const f32x4 w = *(const LAS f32x4*)(scr + i * 256 + c); a[i] += w[0] * t[0]; a[i] += w[1] * t[1]; a[i] += w[2] * t[2]; a[i] += w[3] * t[3]; }
        }
        u32x4 o; o.x = cvt_pk_bf16(a[0], a[1]); o.y = cvt_pk_bf16(a[2], a[3]); o.z = cvt_pk_bf16(a[4], a[5]); o.w = cvt_pk_bf16(a[6], a[7]);
        *(u32x4*)(F.W0t + (size_t)(g * 256 + P) * 1024 + kb * 8) = o;
        asm volatile("s_waitcnt lgkmcnt(0)" ::: "memory");
    }
    { const f32x4* gr = (const f32x4*)F.n0 + F.lane; f32x4 gg[4];
#pragma unroll
      for (int j = 0; j < 4; ++j) gg[j] = gr[64 * j];
      for (int m0 = gw * 2; m0 < MROWS; m0 += NGW * 2) {
        f32x4 v[2][4]; float s[2];
#pragma unroll
        for (int r = 0; r < 2; ++r) { const f32x4* xr = (const f32x4*)(F.x + (size_t)(m0 + r) * DM) + F.lane;
#pragma unroll
            for (int j = 0; j < 4; ++j) v[r][j] = xr[64 * j]; }
#pragma unroll
        for (int r = 0; r < 2; ++r) { s[r] = 0.f;
#pragma unroll
            for (int j = 0; j < 4; ++j) s[r] += (v[r][j][0] * v[r][j][0] + v[r][j][1] * v[r][j][1]) + (v[r][j][2] * v[r][j][2] + v[r][j][3] * v[r][j][3]); }
#pragma unroll
        for (int r = 0; r < 2; ++r) { const float rstd = 1.0f / sqrtf(wave_sum(s[r]) * (1.0f / DM) + EPS);
            u32x2* o8 = (u32x2*)(F.HB + (size_t)(m0 + r) * DM) + F.lane;
#pragma unroll
            for (int j = 0; j < 4; ++j) { u32x2 w; w.x = cvt_pk_bf16(v[r][j][0] * rstd * gg[j][0], v[r][j][1] * rstd * gg[j][1]); w.y = cvt_pk_bf16(v[r][j][2] * rstd * gg[j][2], v[r][j][3] * rstd * gg[j][3]); o8[64 * j] = w; } }
      } }
}

__device__ __forceinline__ bf16x8 rot_negre(const bf16x8 x) {
    u32x4 d = __builtin_bit_cast(u32x4, x);
#pragma unroll
    for (int i = 0; i < 4; ++i) d[i] = __builtin_amdgcn_alignbit(d[i], d[i], 16) ^ 0x80000000u;
    return __builtin_bit_cast(bf16x8, d);
}
__device__ __forceinline__ int f3swz(int R3) { return (R3 & 8) | ((R3 & 7) ^ ((R3 >> 3) & 7)); }
__device__ __forceinline__ void p2_fft(Frame& F) {
    LAS unsigned char* D = F.lds; LAS unsigned char* CM = F.lds + 131072;
    const int tid = F.tid, lane = F.lane, w = F.wave, fr = lane & 15, fq = lane >> 4;
    for (int e = tid; e < 4096; e += NTHREADS) { const int k = e >> 6, n = e & 63; float s, c; sincospif((float)((k * n) & 63) * (1.0f / 32.0f), &s, &c);
        *(LAS unsigned*)(CM + k * 256 + (((n >> 2) ^ (k & 15)) * 16) + (n & 3) * 4) = cvt_pk_bf16(c * 0.125f, s * 0.125f); }
    __syncthreads();
    u32x4 zv[16];
    if (F.bx < 1024) { const bf16_t* Zs0 = F.BA + ((size_t)(F.bx >> 4) * 16 + (F.bx & 15)) * (4096 * 16); const int half = lane & 1, n2 = w * 8 + ((lane >> 1) & 7), n1l = (lane >> 4) & 3;
#pragma unroll
        for (int i = 0; i < 16; ++i) zv[i] = *(const u32x4*)(Zs0 + ((i * 4 + n1l) * 64 + n2) * 16 + half * 8); }
    for (int item = F.bx; item < 1024; item += F.G) {
        int lanev = lane; asm volatile("" : "+v"(lanev));
        const int frv = lanev & 15, fqv = lanev >> 4, tidv = w * 64 + lanev;
        const int bg = item >> 4, slab = item & 15;
        const size_t ibase = ((size_t)bg * 16 + slab) * (4096 * 16);
        const bf16_t* Gs = F.BB + ibase; bf16_t* Ys = F.BC + ibase;
        { const int half = lanev & 1, n2 = w * 8 + ((lanev >> 1) & 7), n1l = (lanev >> 4) & 3;
#pragma unroll
            for (int i = 0; i < 16; ++i) { const int n1 = i * 4 + n1l;
#pragma unroll
                for (int d = 0; d < 4; ++d) { const int R1 = (half * 4 + d) * 64 + n2; *(LAS unsigned*)(D + R1 * 256 + (((n1 >> 2) ^ (R1 & 15)) * 16) + (n1 & 3) * 4) = zv[i][d]; } } }
        __syncthreads();
        f32x4 aR[4][4], aI[4][4];
#pragma unroll
        for (int a = 0; a < 4; ++a)
#pragma unroll
            for (int kb = 0; kb < 4; ++kb) { aR[a][kb] = (f32x4){0.f, 0.f, 0.f, 0.f}; aI[a][kb] = (f32x4){0.f, 0.f, 0.f, 0.f}; }
#pragma unroll 1
        for (int ks = 0; ks < 4; ++ks) { const int ch = ((ks * 4 + fqv) ^ frv) * 16;
            bf16x8 Y[4], X[4];
#pragma unroll
            for (int kb = 0; kb < 4; ++kb) Y[kb] = *(const LAS bf16x8*)(CM + (kb * 16 + frv) * 256 + ch);
#pragma unroll
            for (int a = 0; a < 4; ++a) X[a] = *(const LAS bf16x8*)(D + (w * 64 + a * 16 + frv) * 256 + ch);
#pragma unroll
            for (int a = 0; a < 4; ++a) { const bf16x8 Xs = rot_negre(X[a]);
#pragma unroll
                for (int kb = 0; kb < 4; ++kb) { aR[a][kb] = __builtin_amdgcn_mfma_f32_16x16x32_bf16(X[a], Y[kb], aR[a][kb], 0, 0, 0); aI[a][kb] = __builtin_amdgcn_mfma_f32_16x16x32_bf16(Xs, Y[kb], aI[a][kb], 0, 0, 0); } } }
        __syncthreads();
#pragma unroll
        for (int a = 0; a < 4; ++a)
#pragma unroll
            for (int kb = 0; kb < 4; ++kb) { const int k1 = kb * 16 + frv, R3 = k1 * 8 + w; float o[8];
#pragma unroll
                for (int v = 0; v < 4; ++v) { const int n2 = a * 16 + fqv * 4 + v; const float ang = (float)((n2 * k1) & 4095) * (1.0f / 4096.0f);
                    const float c = __builtin_amdgcn_cosf(ang), s = __builtin_amdgcn_sinf(ang), tr = aR[a][kb][v], ti = aI[a][kb][v];
                    o[2 * v] = tr * c + ti * s; o[2 * v + 1] = ti * c - tr * s; }
                u32x4 pk; pk.x = cvt_pk_bf16(o[0], o[1]); pk.y = cvt_pk_bf16(o[2], o[3]); pk.z = cvt_pk_bf16(o[4], o[5]); pk.w = cvt_pk_bf16(o[6], o[7]);
                *(LAS u32x4*)(D + R3 * 256 + (((a * 4 + fqv) ^ f3swz(R3)) * 16)) = pk; }
        __syncthreads();
        f32x4 c3[4][4], cI[4][4];
#pragma unroll
        for (int a = 0; a < 4; ++a)
#pragma unroll
            for (int kb = 0; kb < 4; ++kb) { c3[a][kb] = (f32x4){0.f, 0.f, 0.f, 0.f}; cI[a][kb] = (f32x4){0.f, 0.f, 0.f, 0.f}; }
#pragma unroll 1
        for (int ks = 0; ks < 4; ++ks) {
            bf16x8 Y[4], X[4];
#pragma unroll
            for (int kb = 0; kb < 4; ++kb) Y[kb] = *(const LAS bf16x8*)(CM + (kb * 16 + frv) * 256 + (((ks * 4 + fqv) ^ frv) * 16));
#pragma unroll
            for (int jj = 0; jj < 4; ++jj) { const int R3 = (w * 4 + jj) * 16 + frv; X[jj] = *(const LAS bf16x8*)(D + R3 * 256 + (((ks * 4 + fqv) ^ f3swz(R3)) * 16)); }
#pragma unroll
            for (int jj = 0; jj < 4; ++jj) {
#pragma unroll
                for (int kb = 0; kb < 4; ++kb) c3[jj][kb] = __builtin_amdgcn_mfma_f32_16x16x32_bf16(X[jj], Y[kb], c3[jj][kb], 0, 0, 0);
                if (slab == 0) { const bf16x8 Xs = rot_negre(X[jj]);
#pragma unroll
                    for (int kb = 0; kb < 4; ++kb) cI[jj][kb] = __builtin_amdgcn_mfma_f32_16x16x32_bf16(Xs, Y[kb], cI[jj][kb], 0, 0, 0); } } }
        __syncthreads();
#pragma unroll
        for (int jj = 0; jj < 4; ++jj)
#pragma unroll
            for (int kb = 0; kb < 4; ++kb) { const int k1 = 2 * (w * 4 + jj) + (fqv >> 1), k2 = kb * 16 + frv, k = k1 + 64 * k2;
                u32x2 pk; pk.x = cvt_pk_bf16(c3[jj][kb][0], c3[jj][kb][1]); pk.y = cvt_pk_bf16(c3[jj][kb][2], c3[jj][kb][3]);
                *(LAS u32x2*)(D + (k + k2) * 16 + (fqv & 1) * 8) = pk;
                if (slab == 0 && (fqv & 1) == 0) *(LAS float*)(D + 98304 + k * 4) = cI[jj][kb][0]; }
        { const int it2 = (item + F.G < 1024) ? item + F.G : item;
            const bf16_t* Zn = F.BA + ((size_t)(it2 >> 4) * 16 + (it2 & 15)) * (4096 * 16); const int half = lanev & 1, n2 = w * 8 + ((lanev >> 1) & 7), n1l = (lanev >> 4) & 3;
#pragma unroll
            for (int i = 0; i < 16; ++i) zv[i] = *(const u32x4*)(Zn + ((i * 4 + n1l) * 64 + n2) * 16 + half * 8); }
        u32x4 gt[8];
#pragma unroll
        for (int i = 0; i < 8; ++i) gt[i] = *(const u32x4*)(Gs + (size_t)(tidv + NTHREADS * i) * 8);
        __syncthreads();
#pragma unroll
        for (int i = 0; i < 16; ++i) { const int q = tidv + NTHREADS * i, k = q >> 1, half = q & 1, km = (4096 - k) & 4095;
            const u32x4 a = *(const LAS u32x4*)(D + (k + (k >> 6)) * 16), bm = *(const LAS u32x4*)(D + (km + (km >> 6)) * 16);
            const u32x4 src = half ? bm : a; float vals[8];
#pragma unroll
            for (int d = 0; d < 4; ++d) { vals[2 * d] = bf_lo(src[d]); vals[2 * d + 1] = bf_hi(src[d]); }
            if (slab == 0) { if (half == 0) vals[0] = 0.5f * (bf_lo(a[0]) + bf_lo(bm[0])); else vals[0] = 0.5f * (*(const LAS float*)(D + 98304 + k * 4) + *(const LAS float*)(D + 98304 + km * 4)); }
            u32x4 o;
#pragma unroll
            for (int d = 0; d < 4; ++d) o[d] = cvt_pk_bf16(vals[2 * d] * bf_lo(gt[i & 7][d]), vals[2 * d + 1] * bf_hi(gt[i & 7][d]));
            if (i < 8) gt[i] = *(const u32x4*)(Gs + (size_t)(tidv + NTHREADS * (i + 8)) * 8);
            *(u32x4*)(Ys + (size_t)q * 8) = o; }
        __syncthreads();
    }
}

__device__ __forceinline__ int vswz(int row) { return (row & 15) ^ ((row >> 5) & 3); }
template <bool DUMMY> __device__ __forceinline__ void p5_sgu(Frame& F) {
    LAS unsigned char* VT = F.lds; LAS unsigned char* WS = F.lds + 65536;
    const int tid = F.tid, lane = F.lane, w = F.wave, fr = lane & 15, fq = lane >> 4;
    u32x4 pva[4], pvb[4]; float ps0 = 0.f, ps1 = 0.f;
    LAS f32x2* STAT = (LAS f32x2*)(F.lds + 98304);
#define SGU_VLOAD(it_) do { const int g_ = (it_) & 7, n_ = ((it_) >> 3) & 31, b_ = (it_) >> 8, r_ = b_ * 4096 + n_ * 128, c_ = g_ * 256 + (lv_ & 31) * 8; \
        _Pragma("unroll") for (int j = 0; j < 4; ++j) { const int r0 = r_ + 2 * ((w * 2 + (lv_ >> 5)) + 16 * j); \
            pva[j] = *(const u32x4*)(F.BB + (size_t)r0 * EI + c_); pvb[j] = *(const u32x4*)(F.BB + (size_t)(r0 + 1) * EI + c_); } \
        if (w < 2) { ps0 = F.vsum[r_ + w * 64 + lv_]; ps1 = F.vsq[r_ + w * 64 + lv_]; } } while (0)
#define SGU_STAT() do { if (w < 2) { const float mu_ = ps0 * (1.0f / EI); STAT[w * 64 + lane] = (f32x2){mu_, __builtin_amdgcn_rsqf(fmaxf(ps1 * (1.0f / EI) - mu_ * mu_, 0.f) + EPS)}; } } while (0)
    if (F.bx < 2048) { const int lv_ = lane; SGU_VLOAD(F.bx); SGU_STAT(); }
    __syncthreads();
    for (int item = F.bx; item < 2048; item += F.G) {
        int lanev = lane; asm volatile("" : "+v"(lanev));
        const int frv = lanev & 15, fqv = lanev >> 4, tidv = w * 64 + lanev;
        const int g = item & 7, n = (item >> 3) & 31, b = item >> 8, row0 = b * 4096 + n * 128, col0 = g * 256;
        u32x4 uu[8], zz[8];
#pragma unroll
        for (int jp = 0; jp < 8; ++jp) { const size_t off = (size_t)(row0 + jp * 16 + frv) * EI + col0 + w * 32 + fqv * 8; uu[jp] = *(const u32x4*)(F.BA + off); zz[jp] = *(const u32x4*)(F.BC + off); }
#pragma unroll
        for (int i = 0; i < 4; ++i) { const int idx = tidv + NTHREADS * i, p = idx >> 4, qc = idx & 15; const float* src = F.wsp + ((size_t)g * 128 + p) * 128 + qc * 8;
            const f32x4 a0 = *(const f32x4*)src, a1 = *(const f32x4*)(src + 4);
            *(LAS u32x4*)(WS + p * 256 + ((qc ^ (p & 15)) * 16)) = pack8(a0, a1); }
        { const int c8 = tidv & 31; float gam[8], bet[8];
            { const f32x4 g0 = *(const f32x4*)(F.lng + col0 + c8 * 8), g1 = *(const f32x4*)(F.lng + col0 + c8 * 8 + 4), b0 = *(const f32x4*)(F.lnb + col0 + c8 * 8), b1 = *(const f32x4*)(F.lnb + col0 + c8 * 8 + 4);
#pragma unroll
                for (int i = 0; i < 4; ++i) { gam[i] = g0[i]; gam[4 + i] = g1[i]; bet[i] = b0[i]; bet[4 + i] = b1[i]; } }
#pragma unroll
            for (int j = 0; j < 4; ++j) { const int q = 2 * ((tidv >> 5) + 16 * j);
                const u32x4 va = pva[j], vb = pvb[j];
                const f32x4 st = *(const LAS f32x4*)(STAT + q); const float mu0 = st[0], rs0 = st[1], mu1 = st[2], rs1 = st[3];
#pragma unroll
                for (int i = 0; i < 8; ++i) { const float x0 = (i & 1) ? bf_hi(va[i >> 1]) : bf_lo(va[i >> 1]), x1 = (i & 1) ? bf_hi(vb[i >> 1]) : bf_lo(vb[i >> 1]);
                    const float y0 = (x0 - mu0) * rs0 * gam[i] + bet[i], y1 = (x1 - mu1) * rs1 * gam[i] + bet[i];
                    const int c = c8 * 8 + i, cl = c & 31, row = (c & ~31) + 16 * ((cl >> 2) & 1) + 4 * (cl >> 3) + (cl & 3);
                    *(LAS unsigned*)(VT + row * 256 + (((q >> 3) ^ vswz(row)) * 16) + (q & 7) * 2) = cvt_pk_bf16(y0, y1); } } }
        { const int it2 = (item + F.G < 2048) ? item + F.G : item; const int lv_ = lanev; SGU_VLOAD(it2); }
        __syncthreads();
        f32x4 acc[2][8];
#pragma unroll
        for (int nn = 0; nn < 2; ++nn)
#pragma unroll
            for (int jp = 0; jp < 8; ++jp) acc[nn][jp] = (f32x4){0.f, 0.f, 0.f, 0.f};
#pragma unroll 1
        for (int ks = 0; ks < 4; ++ks) { bf16x8 X[2], Y[8];
#pragma unroll
            for (int nn = 0; nn < 2; ++nn) { const int row = w * 32 + nn * 16 + frv; X[nn] = *(const LAS bf16x8*)(VT + row * 256 + (((ks * 4 + fqv) ^ vswz(row)) * 16)); }
#pragma unroll
            for (int jp = 0; jp < 8; ++jp) Y[jp] = *(const LAS bf16x8*)(WS + (jp * 16 + frv) * 256 + (((ks * 4 + fqv) ^ frv) * 16));
#pragma unroll
            for (int nn = 0; nn < 2; ++nn)
#pragma unroll
                for (int jp = 0; jp < 8; ++jp) acc[nn][jp] = __builtin_amdgcn_mfma_f32_16x16x32_bf16(X[nn], Y[jp], acc[nn][jp], 0, 0, 0); }
#pragma unroll
        for (int jp = 0; jp < 8; ++jp) { const int p = jp * 16 + frv; const float bs = F.bsp[g * 128 + p]; u32x4 o;
#pragma unroll
            for (int d = 0; d < 4; ++d) { const f32x4 a = acc[d >> 1][jp]; const float m0 = a[(d & 1) * 2] + bs, m1 = a[(d & 1) * 2 + 1] + bs;
                o[d] = cvt_pk_bf16(bf_lo(uu[jp][d]) * m0 * bf_lo(zz[jp][d]), bf_hi(uu[jp][d]) * m1 * bf_hi(zz[jp][d])); }
            { const size_t oo = (size_t)(row0 + p) * EI + col0 + w * 32 + fqv * 8; if (DUMMY) *(u32x4*)(F.HB + (oo & ((size_t)MROWS * DM - 1))) = o; else *(u32x4*)(F.BA + oo) = o; } }
        SGU_STAT();
        __syncthreads();
    }
}

#undef SGU_VLOAD
#undef SGU_STAT
__device__ __forceinline__ void p7_final(Frame& F) {
    const int gw = F.bx * NWAVES + F.wave, NGW = F.G * NWAVES;
    const f32x4 g0 = *((const f32x4*)F.nf + 2 * F.lane), g1 = *((const f32x4*)F.nf + 2 * F.lane + 1), g2 = *((const f32x4*)F.nf + 128 + 2 * F.lane), g3 = *((const f32x4*)F.nf + 128 + 2 * F.lane + 1);
    for (int m0 = gw * 2; m0 < MROWS; m0 += NGW * 2) {
        u32x4 a[2], b[2]; float rstd[2];
#pragma unroll
        for (int r = 0; r < 2; ++r) { const u32x4* xr = (const u32x4*)(F.HB + (size_t)(m0 + r) * DM); a[r] = xr[F.lane]; b[r] = xr[64 + F.lane]; rstd[r] = __builtin_amdgcn_rsqf(F.ss2[m0 + r] * (1.0f / DM) + EPS); }
#pragma unroll
        for (int r = 0; r < 2; ++r) { f32x4* o = (f32x4*)(F.out + (size_t)(m0 + r) * DM); const float rs = rstd[r];
            o[2 * F.lane]           = (f32x4){bf_lo(a[r].x), bf_hi(a[r].x), bf_lo(a[r].y), bf_hi(a[r].y)} * g0 * rs;
            o[2 * F.lane + 1]       = (f32x4){bf_lo(a[r].z), bf_hi(a[r].z), bf_lo(a[r].w), bf_hi(a[r].w)} * g1 * rs;
            o[128 + 2 * F.lane]     = (f32x4){bf_lo(b[r].x), bf_hi(b[r].x), bf_lo(b[r].y), bf_hi(b[r].y)} * g2 * rs;
            o[128 + 2 * F.lane + 1] = (f32x4){bf_lo(b[r].z), bf_hi(b[r].z), bf_lo(b[r].w), bf_hi(b[r].w)} * g3 * rs; }
    }
}

__global__ void __launch_bounds__(NTHREADS, 2) fwd_megakernel(Args args) {
    extern __shared__ __attribute__((aligned(16))) unsigned char lds_raw[];
    cg::grid_group grid = cg::this_grid();
    Frame F;
    F.lds = (LAS unsigned char*)lds_raw; F.tid = threadIdx.x; F.lane = F.tid & 63; F.wave = __builtin_amdgcn_readfirstlane(F.tid >> 6); F.G = gridDim.x; F.bx = blockIdx.x;
    F.x = args.in[0]; F.n0 = args.in[1]; F.win0 = args.in[2]; F.wout0 = args.in[3]; F.n1 = args.in[4]; F.win1 = args.in[5]; F.lng = args.in[6]; F.lnb = args.in[7];
    F.wsp = args.in[8]; F.bsp = args.in[9]; F.wout1 = args.in[10]; F.nf = args.in[11]; F.out = args.out;
    unsigned char* ws = args.ws;
    F.ss1 = (float*)(ws + WS_SS1); F.vsum = (float*)(ws + WS_VSUM); F.vsq = (float*)(ws + WS_VSQ); F.ss2 = (float*)(ws + WS_SS2);
    F.W0t = (bf16_t*)(ws + WS_W0T); F.Wo0t = (bf16_t*)(ws + WS_WO0T); F.W1t = (bf16_t*)(ws + WS_W1T); F.Wo1t = (bf16_t*)(ws + WS_WO1T);
    F.HB = (bf16_t*)(ws + WS_HB); F.BA = (bf16_t*)(ws + WS_BUFA); F.BB = (bf16_t*)(ws + WS_BUFB); F.BC = (bf16_t*)(ws + WS_BUFC);

    volatile LAS unsigned* MISC = (volatile LAS unsigned*)(F.lds + MISC_OFF);
    if (F.tid < 32) MISC[F.tid] = 0u;
    __syncthreads();
#ifdef PROBE_A
    unsigned long long ts[9]; int nts = 0;
#define STAMP() do { ts[nts++] = __builtin_amdgcn_s_memrealtime(); } while (0)
#else
#define STAMP() do { } while (0)
#endif
    XcdBarrier bar = xcd_barrier_post((unsigned*)(ws + WS_BAR), MISC);
    if (ws == nullptr) grid.sync();
    STAMP();
    p0_prep(F);
#if defined(DUP) && (DUP & 1)
    p0_prep(F);
#endif
    xcd_barrier(bar); STAMP();
    { pg8::Gemm g{F.HB, F.W0t, MROWS, 4096, DM}; pg8::StaticOrder S; S.init(MROWS, 4096, F.G, F.bx); Epi1 E{F.BA, F.BB};
      pg8::gemm_phase<Epi1, false>(F.lds, g, S, E);
#if defined(DUP) && (DUP & 2)
      __syncthreads(); pg8::gemm_phase<Epi1, false>(F.lds, g, S, E);
#endif
    }
    xcd_barrier(bar); STAMP();
    p2_fft(F);
#if defined(DUP) && (DUP & 4)
    p2_fft(F);
#endif
    xcd_barrier(bar); STAMP();
    { pg8::Gemm g{F.BC, F.Wo0t, MROWS, DM, EI}; pg8::StaticOrder S; S.init(MROWS, DM, F.G, F.bx); EpiRes<true> E{F.x, F.HB, F.ss1};
#if defined(DUP) && (DUP & 8)
      { EpiRes<true> E2{F.x, F.HB, (float*)(ws + 640 * 1024)}; pg8::gemm_phase<EpiRes<true>, true>(F.lds, g, S, E2); __syncthreads(); }
#endif
      pg8::gemm_phase<EpiRes<true>, true>(F.lds, g, S, E); }
    xcd_barrier(bar); STAMP();
    { pg8::Gemm g{F.HB, F.W1t, MROWS, 6144, DM}; pg8::StaticOrder S; S.init(MROWS, 6144, F.G, F.bx); Epi3 E{F.ss1, F.BA, F.vsum, F.vsq};
#if defined(DUP) && (DUP & 16)
      { Epi3 E2{F.ss1, F.BA, (float*)(ws + 640 * 1024), (float*)(ws + 768 * 1024)}; pg8::gemm_phase<Epi3, false>(F.lds, g, S, E2); __syncthreads(); }
#endif
      pg8::gemm_phase<Epi3, false>(F.lds, g, S, E); }
    xcd_barrier(bar); STAMP();
#if defined(DUP) && (DUP & 32)
    p5_sgu<true>(F);
#endif
    p5_sgu<false>(F);
    xcd_barrier(bar); STAMP();
    { pg8::Gemm g{F.BA, F.Wo1t, MROWS, DM, EI}; pg8::StaticOrder S; S.init(MROWS, DM, F.G, F.bx); EpiRes<false> E{nullptr, F.HB, F.ss2};
      pg8::gemm_phase<EpiRes<false>, false>(F.lds, g, S, E); }
    xcd_barrier(bar); STAMP();
    p7_final(F);
#ifdef PROBE_A
    xcd_barrier(bar); STAMP();
    if (F.bx == 0) { const float ta = (float)(ts[PROBE_A + 1] - ts[PROBE_A]) * 0.01f, tb = (float)(ts[PROBE_B + 1] - ts[PROBE_B]) * 0.0001f;
        for (int i = 1 + F.tid; i < MROWS * DM / 16; i += NTHREADS) F.out[i] += tb;
        if (F.tid == 0) F.out[0] = ta; }
#endif
}

extern "C" void kernel_launch(void* const* d_in, const int* in_sizes, int n_in, void* d_out, int out_size, void* d_ws, size_t ws_size, hipStream_t stream) {
    static int grid = 0;
    if (!grid) {
        if (n_in != 12 || in_sizes[0] != MROWS * DM || out_size != MROWS * DM || ws_size < WS_END) {
            fprintf(stderr, "kernel_launch: unexpected problem (n_in %d, in0 %d, out %d, ws %zu); nothing launched\n", n_in, in_sizes[0], out_size, ws_size); grid = -1; return; }
        int dev = 0, cus = 0, per_cu = 0;
        if (hipGetDevice(&dev) != hipSuccess || hipDeviceGetAttribute(&cus, hipDeviceAttributeMultiprocessorCount, dev) != hipSuccess) { grid = -1; return; }
        if (hipFuncSetAttribute((const void*)fwd_megakernel, hipFuncAttributeMaxDynamicSharedMemorySize, LDS_BYTES) != hipSuccess) { fprintf(stderr, "kernel_launch: hipFuncSetAttribute failed\n"); grid = -1; return; }
        if (hipOccupancyMaxActiveBlocksPerMultiprocessor(&per_cu, (const void*)fwd_megakernel, NTHREADS, LDS_BYTES) != hipSuccess || per_cu < 1) per_cu = 1;
        grid = cus * per_cu;
    }
    if (grid < 0) return;
    if (hipMemsetAsync((char*)d_ws + WS_BAR, 0, XCD_BAR_WORDS * 4, stream) != hipSuccess) { fprintf(stderr, "kernel_launch: hipMemsetAsync failed\n"); return; }
    Args a{};
    for (int i = 0; i < 12; ++i) a.in[i] = (const float*)d_in[i];
    a.out = (float*)d_out; a.ws = (unsigned char*)d_ws;
    void* kargs[] = {&a};
    hipError_t e = hipLaunchCooperativeKernel((const void*)fwd_megakernel, dim3(grid), dim3(NTHREADS), kargs, LDS_BYTES, stream);
    if (e != hipSuccess) fprintf(stderr, "kernel_launch: cooperative launch failed: %s (grid %d)\n", hipGetErrorString(e), grid);
}
```

```cpp
#include <hip/hip_runtime.h>
#include <hip/hip_cooperative_groups.h>
#include <cstdio>
#include <cstdint>
namespace cg = cooperative_groups;

#define LAS __attribute__((address_space(3)))
typedef unsigned short bf16_t;
typedef short bf16x8 __attribute__((ext_vector_type(8)));
typedef float f32x4 __attribute__((ext_vector_type(4)));
typedef float f32x2 __attribute__((ext_vector_type(2)));
typedef unsigned u32x4 __attribute__((ext_vector_type(4)));
typedef unsigned u32x2 __attribute__((ext_vector_type(2)));

constexpr int MROWS = 32768, DM = 1024, EI = 2048, SEQ = 4096;
constexpr float EPS = 1e-6f;
constexpr int NTHREADS = 512, NWAVES = 8;
constexpr int LDS_BYTES = 148480;
constexpr size_t MiB = 1u << 20;
constexpr size_t WS_SS1 = 0, WS_VSUM = 128 * 1024, WS_VSQ = 256 * 1024, WS_SS2 = 384 * 1024, WS_BAR = 512 * 1024;
constexpr int MISC_OFF = 147456;
constexpr size_t WS_W0T = 1 * MiB, WS_WO0T = 9 * MiB, WS_W1T = 13 * MiB, WS_WO1T = 25 * MiB;
constexpr size_t WS_HB = 32 * MiB, WS_BUFA = 96 * MiB, WS_BUFB = 224 * MiB, WS_BUFC = 352 * MiB, WS_END = 480 * MiB;

__device__ __forceinline__ unsigned cvt_pk_bf16(float lo, float hi) { unsigned r; asm volatile("v_cvt_pk_bf16_f32 %0, %1, %2" : "=v"(r) : "v"(lo), "v"(hi)); return r; }
__device__ __forceinline__ float bf_lo(unsigned u) { return __uint_as_float(u << 16); }
__device__ __forceinline__ float bf_hi(unsigned u) { return __uint_as_float(u & 0xffff0000u); }
__device__ __forceinline__ float silu_f(float x) { return x * __builtin_amdgcn_rcpf(1.0f + __builtin_amdgcn_exp2f(-1.4426950409f * x)); }
__device__ __forceinline__ float gelu_f(float x) { const float t = x * (1.0f + 0.044715f * x * x); return x * __builtin_amdgcn_rcpf(1.0f + __builtin_amdgcn_exp2f(-2.302208198f * t)); }
__device__ __forceinline__ float wave_sum(float v) {
#pragma unroll
    for (int o = 1; o < 64; o <<= 1) v += __shfl_xor(v, o);
    return v;
}
__host__ __device__ __forceinline__ int chan_of_pos(int p) { const int s = p >> 4, e = p & 15; if (e < 8) return 8 * s + e; const int j = 8 * s + (e - 8); return j == 0 ? 128 : 256 - j; }
__host__ __device__ __forceinline__ int pos_of_chan(int ch) { if (ch < 128) return 16 * (ch >> 3) + (ch & 7); if (ch == 128) return 8; const int j = 256 - ch; return 16 * (j >> 3) + 8 + (j & 7); }

namespace pg8 {
constexpr int BM = 256, BK = 64, HALF = 128, HTB = HALF * BK * 2, STAGE_BYTES = 8 * HTB, NXCD = 8, WGM = 8;
__host__ __device__ __forceinline__ int lds_byte(int r, int c) { const int st = (r >> 4) * 2 + (c >> 5), rr = r & 15, cc = c & 31, ob = rr * 64 + cc * 2; return st * 1024 + (ob ^ (((ob >> 9) & 1) << 5)); }
__host__ __device__ __forceinline__ void stage_rc(int b, int& R, int& C) { const int st = b / 1024, sb = b % 1024, swz = sb ^ (((sb >> 9) & 1) << 5); R = (st >> 1) * 16 + swz / 64; C = (st & 1) * 32 + (swz % 64) / 2; }
__host__ __device__ __forceinline__ int perm32(int rho) { const int n = rho >> 4, i = rho & 15; return 8 * (i >> 2) + 4 * n + (i & 3); }
struct Unit { int pm, pn; };
struct Gemm { const bf16_t* A; const bf16_t* Bt; int M, N, K; };
struct StaticOrder {
    int nM, nN, nwg, G, c;
    __host__ __device__ void init(int M, int N, int G_, int c_) { nM = M / BM; nN = N / BM; nwg = nM * nN; G = G_; c = c_; }
    __host__ __device__ bool next(int i, Unit& u) const {
        const long L = (long)i * G + c; if (L >= nwg) return false;
        int wgid = (int)L; { const int q = nwg / NXCD, r = nwg % NXCD, xcd = wgid % NXCD, off = wgid / NXCD; wgid = (xcd < r ? xcd * (q + 1) : r * (q + 1) + (xcd - r) * q) + off; }
        const int nig = WGM * nN, gid = wgid / nig, fm = gid * WGM, gsz = (nM - fm) < WGM ? (nM - fm) : WGM;
        u.pm = fm + ((wgid % nig) % gsz); u.pn = (wgid % nig) / gsz; return true;
    }
};
template <class Epi, bool ABLK>
__device__ __forceinline__ void gemm_phase(LAS unsigned char* lds, const Gemm g, const StaticOrder& S, const Epi& E) {
    const int tid = threadIdx.x, wid = __builtin_amdgcn_readfirstlane(tid >> 6), lane = tid & 63, wr = wid >> 2, wc = wid & 3, fr = lane & 15, fq = lane >> 4;
    const int K = g.K, nt = K / BK;
    unsigned voffA[2], voffB[2];
#pragma unroll
    for (int i = 0; i < 2; ++i) { int R, C; stage_rc(tid * 16 + i * 8192, R, C); const int Rb = (R & ~31) + perm32(R & 31);
        voffA[i] = ABLK ? (unsigned)((C >> 4) * 65536 + R * 16 + (C & 15)) * 2u : (unsigned)(R * K + C) * 2u; voffB[i] = (unsigned)(Rb * K + C) * 2u; }
    const size_t kstepB = (size_t)(BK * 2), hstepB = (size_t)HALF * K * 2, tstepB = 2 * hstepB;
    const size_t kstepA = ABLK ? (size_t)4 * 65536 * 2 : kstepB, hstepA = ABLK ? (size_t)HALF * 16 * 2 : hstepB;
#define PG8_ABASE(pm) ((const char*)g.A + (ABLK ? ((size_t)((pm) >> 4) * 4096 * 2048 + (size_t)((pm) & 15) * 256 * 16) * 2 : (size_t)(pm) * tstepB))
    const unsigned ldsw = (unsigned)wid * 1024u;
    const int aoff = lds_byte(wr * 64 + fr, fq * 8), boff = lds_byte(wc * 32 + fr, fq * 8);
#define PG8_SA(b, h) (((b) * 2 + (h)) * HTB)
#define PG8_SB(b, h) ((4 + (b) * 2 + (h)) * HTB)
#define PG8_STAGE(bufoff, gbase, voff) do { _Pragma("unroll") for (int _i = 0; _i < 2; ++_i) \
        __builtin_amdgcn_global_load_lds((const unsigned*)((const char*)(gbase) + (voff)[_i]), (LAS unsigned*)(lds + (bufoff) + ldsw + _i * 8192), 16, 0, 0); } while (0)
#define PG8_LDA(dst, b, h) do { _Pragma("unroll") for (int m = 0; m < 4; ++m) _Pragma("unroll") for (int k = 0; k < 2; ++k) dst[m][k] = *(const LAS bf16x8*)(lds + PG8_SA(b, h) + aoff + m * 2048 + k * 1024); } while (0)
#define PG8_LDB(dst, b, h) do { _Pragma("unroll") for (int n = 0; n < 2; ++n) _Pragma("unroll") for (int k = 0; k < 2; ++k) dst[n][k] = *(const LAS bf16x8*)(lds + PG8_SB(b, h) + boff + n * 2048 + k * 1024); } while (0)
#define PG8_MMA(ai, bj, At, Bt) do { __builtin_amdgcn_s_setprio(1); _Pragma("unroll") for (int m = 0; m < 4; ++m) _Pragma("unroll") for (int n = 0; n < 2; ++n) _Pragma("unroll") for (int k = 0; k < 2; ++k) \
        acc[ai][bj][m][n] = __builtin_amdgcn_mfma_f32_16x16x32_bf16(Bt[n][k], At[m][k], acc[ai][bj][m][n], 0, 0, 0); __builtin_amdgcn_s_setprio(0); } while (0)
#define PG8_WAIT_V(n) asm volatile("s_waitcnt vmcnt(" #n ")" ::: "memory")
#define PG8_WAIT_L(n) asm volatile("s_waitcnt lgkmcnt(" #n ")" ::: "memory")
#define PG8_BAR __builtin_amdgcn_s_barrier()
#define PG8_SCHED __builtin_amdgcn_sched_barrier(0)
    Unit cur, nxt; int ui = 0;
    if (!S.next(0, cur)) return;
    f32x4 acc[2][2][4][2];
#pragma unroll
    for (int a = 0; a < 2; ++a)
#pragma unroll
        for (int b = 0; b < 2; ++b)
#pragma unroll
            for (int m = 0; m < 4; ++m)
#pragma unroll
                for (int n = 0; n < 2; ++n) acc[a][b][m][n] = (f32x4){0.f, 0.f, 0.f, 0.f};
    bf16x8 At[4][2], B0[2][2], B1[2][2];
    const char* cA = PG8_ABASE(cur.pm); const char* cB = (const char*)g.Bt + (size_t)cur.pn * tstepB;
    PG8_STAGE(PG8_SB(0, 0), cB, voffB); PG8_STAGE(PG8_SB(0, 1), cB + hstepB, voffB); PG8_STAGE(PG8_SA(0, 0), cA, voffA); PG8_STAGE(PG8_SA(0, 1), cA + hstepA, voffA);
    if (wr == 1) PG8_BAR;
    PG8_WAIT_V(2); PG8_BAR;
    PG8_STAGE(PG8_SB(1, 0), cB + kstepB, voffB); PG8_STAGE(PG8_SA(1, 0), cA + kstepA, voffA); PG8_STAGE(PG8_SB(1, 1), cB + hstepB + kstepB, voffB);
    PG8_WAIT_V(6); PG8_BAR;
    for (;;) {
        const bool has_next = S.next(ui + 1, nxt);
        const char* nA = has_next ? PG8_ABASE(nxt.pm) : cA; const char* nB = has_next ? (const char*)g.Bt + (size_t)nxt.pn * tstepB : cB;
        for (int t = 0; t < nt; t += 2) {
            const bool last = (t == nt - 2);
            const char* a1 = cA + (size_t)(t + 1) * kstepA;
            const char* a2 = last ? nA : cA + (size_t)(t + 2) * kstepA; const char* b2 = last ? nB : cB + (size_t)(t + 2) * kstepB;
            const char* a3 = a2 + kstepA; const char* b3 = b2 + kstepB;
            PG8_LDB(B0, 0, 0); PG8_LDB(B1, 0, 1); PG8_SCHED; PG8_LDA(At, 0, 0); PG8_STAGE(PG8_SA(1, 1), a1 + hstepA, voffA);
            PG8_WAIT_V(8); PG8_WAIT_L(0); PG8_BAR; PG8_MMA(0, 0, At, B0); PG8_MMA(0, 1, At, B1); PG8_BAR; PG8_SCHED;
            PG8_LDA(At, 0, 1); PG8_STAGE(PG8_SB(0, 0), b2, voffB); PG8_STAGE(PG8_SB(0, 1), b2 + hstepB, voffB); PG8_STAGE(PG8_SA(0, 0), a2, voffA);
            PG8_WAIT_V(8); PG8_WAIT_L(0); PG8_BAR; PG8_MMA(1, 0, At, B0); PG8_MMA(1, 1, At, B1); PG8_BAR; PG8_SCHED;
            PG8_LDB(B0, 1, 0); PG8_LDB(B1, 1, 1); PG8_SCHED; PG8_LDA(At, 1, 0); PG8_STAGE(PG8_SA(0, 1), a2 + hstepA, voffA);
            PG8_WAIT_V(8); PG8_WAIT_L(0); PG8_BAR; PG8_MMA(0, 0, At, B0); PG8_MMA(0, 1, At, B1); PG8_BAR; PG8_SCHED;
            PG8_LDA(At, 1, 1); PG8_STAGE(PG8_SB(1, 0), b3, voffB); PG8_STAGE(PG8_SB(1, 1), b3 + hstepB, voffB); PG8_STAGE(PG8_SA(1, 0), a3, voffA);
            PG8_WAIT_V(8); PG8_WAIT_L(0); PG8_BAR; PG8_MMA(1, 0, At, B0); PG8_MMA(1, 1, At, B1); PG8_BAR; PG8_SCHED;
        }
        if (wr == 0) PG8_BAR;
        E(acc, cur, wr, wc, fr, fq);
        if (!has_next) break;
#pragma unroll
        for (int a = 0; a < 2; ++a)
#pragma unroll
            for (int b = 0; b < 2; ++b)
#pragma unroll
                for (int m = 0; m < 4; ++m)
#pragma unroll
                    for (int n = 0; n < 2; ++n) acc[a][b][m][n] = (f32x4){0.f, 0.f, 0.f, 0.f};
        cur = nxt; cA = nA; cB = nB; ++ui;
        if (wr == 1) PG8_BAR;
    }
    PG8_WAIT_V(0);
    PG8_BAR;
#undef PG8_ABASE
#undef PG8_SA
#undef PG8_SB
#undef PG8_STAGE
#undef PG8_LDA
#undef PG8_LDB
#undef PG8_MMA
#undef PG8_WAIT_V
#undef PG8_WAIT_L
#undef PG8_BAR
#undef PG8_SCHED
}
}

__device__ __forceinline__ u32x4 pack8(const f32x4 v0, const f32x4 v1) { u32x4 w; w.x = cvt_pk_bf16(v0[0], v0[1]); w.y = cvt_pk_bf16(v0[2], v0[3]); w.z = cvt_pk_bf16(v1[0], v1[1]); w.w = cvt_pk_bf16(v1[2], v1[3]); return w; }

struct Epi1 {
    bf16_t* Z; bf16_t* SZ;
    __device__ __forceinline__ void operator()(const f32x4 (&acc)[2][2][4][2], const pg8::Unit& u, int wr, int wc, int fr, int fq) const {
        const int b = u.pm >> 4, t0 = (u.pm & 15) * 256 + wr * 64 + fr; const bool gate = u.pn >= 8; const int g = u.pn & 7;
        bf16_t* base = (gate ? SZ : Z) + (size_t)(b * 8 + g) * (16 * 4096 * 16);
#pragma unroll
        for (int ai = 0; ai < 2; ++ai)
#pragma unroll
            for (int m = 0; m < 4; ++m) { const int t = t0 + ai * 128 + m * 16;
#pragma unroll
                for (int bj = 0; bj < 2; ++bj) { const int cgp = bj * 128 + wc * 32 + fq * 8, s = cgp >> 4, e0 = cgp & 8;
                    f32x4 v0 = acc[ai][bj][m][0], v1 = acc[ai][bj][m][1];
                    if (gate) {
#pragma unroll
                        for (int j = 0; j < 4; ++j) { v0[j] = silu_f(v0[j]); v1[j] = silu_f(v1[j]); } }
                    *(u32x4*)(base + ((size_t)s * 4096 + t) * 16 + e0) = pack8(v0, v1); } }
    }
};
template <bool FIRST> struct EpiRes {
    const float* XIN; bf16_t* XB; float* SS;
    __device__ __forceinline__ void operator()(const f32x4 (&acc)[2][2][4][2], const pg8::Unit& u, int wr, int wc, int fr, int fq) const {
        const int row0 = u.pm * 256 + wr * 64 + fr, col0 = u.pn * 256 + wc * 32 + fq * 8;
#pragma unroll
        for (int ai = 0; ai < 2; ++ai)
#pragma unroll
            for (int m = 0; m < 4; ++m) { const int row = row0 + ai * 128 + m * 16; float ss = 0.f;
#pragma unroll
                for (int bj = 0; bj < 2; ++bj) { const size_t off = (size_t)row * DM + col0 + bj * 128; f32x4 x0, x1;
                    if (FIRST) { x0 = *(const f32x4*)(XIN + off); x1 = *(const f32x4*)(XIN + off + 4); }
                    else { const u32x4 r = *(const u32x4*)(XB + off); x0 = (f32x4){bf_lo(r.x), bf_hi(r.x), bf_lo(r.y), bf_hi(r.y)}; x1 = (f32x4){bf_lo(r.z), bf_hi(r.z), bf_lo(r.w), bf_hi(r.w)}; }
                    const f32x4 v0 = acc[ai][bj][m][0] + x0, v1 = acc[ai][bj][m][1] + x1;
                    *(u32x4*)(XB + off) = pack8(v0, v1);
                    ss += (v0[0] * v0[0] + v0[1] * v0[1]) + (v0[2] * v0[2] + v0[3] * v0[3]) + (v1[0] * v1[0] + v1[1] * v1[1]) + (v1[2] * v1[2] + v1[3] * v1[3]); }
                ss += __shfl_xor(ss, 16); ss += __shfl_xor(ss, 32);
                if (fq == 0) atomicAdd(SS + row, ss); }
    }
};
struct Epi3 {
    const float* SS1; bf16_t* UZ; bf16_t* V; float* VSUM; float* VSQ;
    __device__ __forceinline__ void operator()(const f32x4 (&acc)[2][2][4][2], const pg8::Unit& u, int wr, int wc, int fr, int fq) const {
        const int row0 = u.pm * 256 + wr * 64 + fr;
        if (u.pn < 16) {
            const int col0 = u.pn * 128 + wc * 32 + fq * 8;
#pragma unroll
            for (int ai = 0; ai < 2; ++ai)
#pragma unroll
                for (int m = 0; m < 4; ++m) { const int row = row0 + ai * 128 + m * 16;
                    const float rs = __builtin_amdgcn_rsqf(SS1[row] * (1.0f / DM) + EPS);
                    f32x4 v0 = acc[ai][0][m][0] * rs, v1 = acc[ai][0][m][1] * rs; const f32x4 z0 = acc[ai][1][m][0] * rs, z1 = acc[ai][1][m][1] * rs;
#pragma unroll
                    for (int j = 0; j < 4; ++j) { v0[j] = gelu_f(v0[j]) * silu_f(z0[j]); v1[j] = gelu_f(v1[j]) * silu_f(z1[j]); }
                    *(u32x4*)(UZ + (size_t)row * EI + col0) = pack8(v0, v1); }
        } else {
            const int col0 = (u.pn - 16) * 256 + wc * 32 + fq * 8;
#pragma unroll
            for (int ai = 0; ai < 2; ++ai)
#pragma unroll
                for (int m = 0; m < 4; ++m) { const int row = row0 + ai * 128 + m * 16;
                    const float rs = __builtin_amdgcn_rsqf(SS1[row] * (1.0f / DM) + EPS); float s1 = 0.f, s2 = 0.f;
#pragma unroll
                    for (int bj = 0; bj < 2; ++bj) { f32x4 v0 = acc[ai][bj][m][0] * rs, v1 = acc[ai][bj][m][1] * rs;
#pragma unroll
                        for (int j = 0; j < 4; ++j) { v0[j] = gelu_f(v0[j]); v1[j] = gelu_f(v1[j]); }
                        s1 += (v0[0] + v0[1]) + (v0[2] + v0[3]) + (v1[0] + v1[1]) + (v1[2] + v1[3]);
                        s2 += (v0[0] * v0[0] + v0[1] * v0[1]) + (v0[2] * v0[2] + v0[3] * v0[3]) + (v1[0] * v1[0] + v1[1] * v1[1]) + (v1[2] * v1[2] + v1[3] * v1[3]);
                        *(u32x4*)(V + (size_t)row * EI + col0 + bj * 128) = pack8(v0, v1); }
                    s1 += __shfl_xor(s1, 16); s1 += __shfl_xor(s1, 32); s2 += __shfl_xor(s2, 16); s2 += __shfl_xor(s2, 32);
                    if (fq == 0) { atomicAdd(VSUM + row, s1); atomicAdd(VSQ + row, s2); } }
        }
    }
};


#define XB_TMO      128
#define XB_XCNT(j)  (256  + 64 * (j))
#define XB_XSUB(j)  (1280 + 64 * (j))
#define XB_XGEN(j)  (2304 + 64 * (j))
#define XB_TOP      3328
#define XB_TOPGEN   3392
#define XCD_BAR_WORDS 3456
#define XB_SPIN_CAP (1u << 18)
__device__ __forceinline__ unsigned xb_ld(unsigned* p)              { return __hip_atomic_load(p, __ATOMIC_RELAXED, __HIP_MEMORY_SCOPE_AGENT); }
__device__ __forceinline__ unsigned xb_add(unsigned* p, unsigned v) { return __hip_atomic_fetch_add(p, v, __ATOMIC_RELAXED, __HIP_MEMORY_SCOPE_AGENT); }
__device__ __forceinline__ unsigned xb_xcc_id() { return (unsigned)__builtin_amdgcn_s_getreg((3 << 11) | 20) & 0xFu; }
#define XB_SPIN(cond, bar) do { unsigned _sp = 0; while (cond) { __builtin_amdgcn_s_sleep(1); \
    if ((++_sp & 255u) == 0u) { if (xb_ld(&(bar)[XB_TMO])) break; if (_sp > XB_SPIN_CAP) { atomicAdd(&(bar)[XB_TMO], 1u); break; } } } } while (0)
struct XcdBarrier { unsigned* bar; unsigned x; volatile LAS unsigned* st; };
__device__ __forceinline__ XcdBarrier xcd_barrier_post(unsigned* bar, volatile LAS unsigned* st) {
    XcdBarrier b; b.bar = bar; b.x = xb_xcc_id(); b.st = st;
    if (threadIdx.x == 0) (void)xb_add(&bar[XB_XCNT(b.x)], 1u);
    return b;
}
__device__ __forceinline__ void xcd_barrier_complete(unsigned* bar, unsigned x, unsigned& nloc, unsigned& nx) {
    const unsigned G = gridDim.x * gridDim.y * gridDim.z;
    unsigned sum, cnt, mine, sp = 0u;
    for (;;) {
        sum = 0u; cnt = 0u; mine = 0u;
#pragma unroll
        for (unsigned j = 0; j < 16; ++j) { const unsigned c = xb_ld(&bar[XB_XCNT(j)]); sum += c; cnt += (c > 0u) ? 1u : 0u; mine = (j == x) ? c : mine; }
        if (sum == G) break;
        __builtin_amdgcn_s_sleep(1);
        if ((++sp & 255u) == 0u) { if (xb_ld(&bar[XB_TMO])) break; if (sp > XB_SPIN_CAP) { atomicAdd(&bar[XB_TMO], 1u); break; } }
    }
    nloc = mine > 0u ? mine : 1u; nx = cnt > 0u ? cnt : 1u;
}
__device__ __forceinline__ void xcd_barrier(const XcdBarrier& b) {
    asm volatile("s_waitcnt vmcnt(0)" ::: "memory");
    __syncthreads();
    if (threadIdx.x == 0) {
        unsigned* bar = b.bar;
        __builtin_amdgcn_s_waitcnt(0);
        unsigned nloc = b.st[0], nx = b.st[1];
        if (nloc == 0u) { xcd_barrier_complete(bar, b.x, nloc, nx); b.st[0] = nloc; b.st[1] = nx; }
        const unsigned old = xb_add(&bar[XB_XSUB(b.x)], 1u);
        const unsigned gen = old / nloc;
        if (old + 1u == (gen + 1u) * nloc) {
            __builtin_amdgcn_fence(__ATOMIC_RELEASE, "agent");
            asm volatile("s_waitcnt vmcnt(0)" ::: "memory");
            const unsigned og = xb_add(&bar[XB_TOP], 1u);
            const unsigned tg = og / nx;
            if (og + 1u == (tg + 1u) * nx) xb_add(&bar[XB_TOPGEN], 1u);
            else XB_SPIN(xb_ld(&bar[XB_TOPGEN]) == tg, bar);
            __builtin_amdgcn_fence(__ATOMIC_ACQUIRE, "agent");
            xb_add(&bar[XB_XGEN(b.x)], 1u);
            asm volatile("s_waitcnt vmcnt(0)" ::: "memory");
        } else {
            XB_SPIN(xb_ld(&bar[XB_XGEN(b.x)]) == gen, bar);
            __builtin_amdgcn_fence(__ATOMIC_ACQUIRE, "agent");
            asm volatile("s_waitcnt vmcnt(0)" ::: "memory");
        }
    }
    __syncthreads();
}

struct Args { const float* in[12]; float* out; unsigned char* ws; };
struct Frame {
    LAS unsigned char* lds; int tid, lane, wave, G, bx;
    const float *x, *n0, *win0, *wout0, *n1, *win1, *lng, *lnb, *wsp, *bsp, *wout1, *nf; float* out;
    float *ss1, *vsum, *vsq, *ss2;
    bf16_t *W0t, *Wo0t, *W1t, *Wo1t, *HB, *BA, *BB, *BC;
};

__device__ __forceinline__ void p0_transpose_item(const float* W, int N, bf16_t* WT, int Kd, LAS float* scr, int k0, int n0, int lane, int mode, const float* kscale) {
#pragma unroll
    for (int i = 0; i < 32; ++i) { const int kk = 2 * i + (lane >> 5), k = k0 + kk; const int sr = (mode == 2) ? ((k & ~255) + chan_of_pos(k & 255)) : k;
        float v = W[(size_t)sr * N + n0 + (lane & 31)]; if (mode == 3) v *= kscale[k]; scr[kk * 33 + (lane & 31)] = v; }
    asm volatile("s_waitcnt lgkmcnt(0)" ::: "memory");
    const int c = lane & 7;
#pragma unroll
    for (int j = 0; j < 4; ++j) { const int n = (lane >> 3) + 8 * j; const LAS float* s = scr + (8 * c) * 33 + n; const int ns = n0 + n;
        const int dr = (mode == 1) ? (2048 + (ns & 0x700) + pos_of_chan(ns & 255)) : (mode == 3) ? (ns < 2048 ? ((ns >> 7) * 256 + (ns & 127)) : ns < 4096 ? (ns + 2048) : (((ns - 4096) >> 7) * 256 + 128 + (ns & 127))) : ns;
        u32x4 o; o.x = cvt_pk_bf16(s[0 * 33], s[1 * 33]); o.y = cvt_pk_bf16(s[2 * 33], s[3 * 33]); o.z = cvt_pk_bf16(s[4 * 33], s[5 * 33]); o.w = cvt_pk_bf16(s[6 * 33], s[7 * 33]);
        *(u32x4*)(WT + (size_t)dr * Kd + k0 + 8 * c) = o; }
    asm volatile("s_waitcnt lgkmcnt(0)" ::: "memory");
}
__device__ __forceinline__ void p0_prep(Frame& F) {
    LAS float* scr = (LAS float*)(F.lds + F.wave * 16384);
    LAS float* costab = (LAS float*)(F.lds + 131072);
    if (F.tid < 256) costab[F.tid] = cospif((float)F.tid * (1.0f / 128.0f)) * (1.0f / 16.0f);
    __syncthreads();
    const int gw = F.bx * NWAVES + F.wave, NGW = F.G * NWAVES;
    for (int i = F.bx * NTHREADS + F.tid; i < 4 * MROWS; i += F.G * NTHREADS) F.ss1[i] = 0.f;
    constexpr int I_A = 16 * 64, I_B = 32 * 32, I_C = 16 * 192, I_D = 32 * 32;
    for (int it = gw; it < I_A + I_B + I_C + I_D; it += NGW) {
        int r = it;
        if (r < I_A) { const int kb = r >> 6, nb = r & 63; p0_transpose_item(F.win0, 4096, F.W0t, 1024, scr, kb * 64, 2048 + nb * 32, F.lane, 1, nullptr); continue; } r -= I_A;
        if (r < I_B) { const int kb = r >> 5, nb = r & 31; p0_transpose_item(F.wout0, 1024, F.Wo0t, 2048, scr, kb * 64, nb * 32, F.lane, 2, nullptr); continue; } r -= I_B;
        if (r < I_C) { const int kb = r / 192, nb = r % 192; p0_transpose_item(F.win1, 6144, F.W1t, 1024, scr, kb * 64, nb * 32, F.lane, 3, F.n1); continue; } r -= I_C;
        { const int kb = r >> 5, nb = r & 31; p0_transpose_item(F.wout1, 1024, F.Wo1t, 2048, scr, kb * 64, nb * 32, F.lane, 0, nullptr); }
    }
    for (int task = gw; task < 4096; task += NGW) {
        const int kb = task >> 5, g = (task >> 2) & 7, pc = task & 3, P = pc * 64 + F.lane;
        const int jeff = (P == 1) ? 128 : (P >> 1), phase = (P >= 3 && (P & 1)) ? 64 : 0;
        const float* wp = F.win0 + (size_t)(kb * 8) * 4096 + g * 256;
#pragma unroll
        for (int i = 0; i < 8; ++i) *(LAS f32x4*)(scr + i * 256 + F.lane * 4) = *(const f32x4*)(wp + (size_t)i * 4096 + F.lane * 4);
        asm volatile("s_waitcnt vmcnt(0) lgkmcnt(0)" ::: "memory");
        float a[8];
#pragma unroll
        for (int i = 0; i < 8; ++i) a[i] = 0.f;
        for (int c = 0; c < 256; c += 4) {
            float t[4];
#pragma unroll
            for (int j = 0; j < 4; ++j) t[j] = costab[(jeff * (c + j) + phase) & 255];
#pragma unroll
            for (int i = 0; i < 8; ++i) { const f32x4 w = *(const LAS f32x4*)(scr + i * 256 + c); a[i] += w[0] * t[0]; a[i] += w[1] * t[1]; a[i] += w[2] * t[2]; a[i] += w[3] * t[3]; }
        }
        u32x4 o; o.x = cvt_pk_bf16(a[0], a[1]); o.y = cvt_pk_bf16(a[2], a[3]); o.z = cvt_pk_bf16(a[4], a[5]); o.w = cvt_pk_bf16(a[6], a[7]);
        *(u32x4*)(F.W0t + (size_t)(g * 256 + P) * 1024 + kb * 8) = o;
        asm volatile("s_waitcnt lgkmcnt(0)" ::: "memory");
    }
    { const f32x4* gr = (const f32x4*)F.n0 + F.lane; f32x4 gg[4];
#pragma unroll
      for (int j = 0; j < 4; ++j) gg[j] = gr[64 * j];
      for (int m0 = gw * 2; m0 < MROWS; m0 += NGW * 2) {
        f32x4 v[2][4]; float s[2];
#pragma unroll
        for (int r = 0; r < 2; ++r) { const f32x4* xr = (const f32x4*)(F.x + (size_t)(m0 + r) * DM) + F.lane;
#pragma unroll
            for (int j = 0; j < 4; ++j) v[r][j] = xr[64 * j]; }
#pragma unroll
        for (int r = 0; r < 2; ++r) { s[r] = 0.f;
#pragma unroll
            for (int j = 0; j < 4; ++j) s[r] += (v[r][j][0] * v[r][j][0] + v[r][j][1] * v[r][j][1]) + (v[r][j][2] * v[r][j][2] + v[r][j][3] * v[r][j][3]); }
#pragma unroll
        for (int r = 0; r < 2; ++r) { const float rstd = 1.0f / sqrtf(wave_sum(s[r]) * (1.0f / DM) + EPS);
            u32x2* o8 = (u32x2*)(F.HB + (size_t)(m0 + r) * DM) + F.lane;
#pragma unroll
            for (int j = 0; j < 4; ++j) { u32x2 w; w.x = cvt_pk_bf16(v[r][j][0] * rstd * gg[j][0], v[r][j][1] * rstd * gg[j][1]); w.y = cvt_pk_bf16(v[r][j][2] * rstd * gg[j][2], v[r][j][3] * rstd * gg[j][3]); o8[64 * j] = w; } }
      } }
}

__device__ __forceinline__ bf16x8 rot_negre(const bf16x8 x) {
    u32x4 d = __builtin_bit_cast(u32x4, x);
#pragma unroll
    for (int i = 0; i < 4; ++i) d[i] = __builtin_amdgcn_alignbit(d[i], d[i], 16) ^ 0x80000000u;
    return __builtin_bit_cast(bf16x8, d);
}
__device__ __forceinline__ int f3swz(int R3) { return (R3 & 8) | ((R3 & 7) ^ ((R3 >> 3) & 7)); }
__device__ __forceinline__ void p2_fft(Frame& F) {
    LAS unsigned char* D = F.lds; LAS unsigned char* CM = F.lds + 131072;
    const int tid = F.tid, lane = F.lane, w = F.wave, fr = lane & 15, fq = lane >> 4;
    for (int e = tid; e < 4096; e += NTHREADS) { const int k = e >> 6, n = e & 63; float s, c; sincospif((float)((k * n) & 63) * (1.0f / 32.0f), &s, &c);
        *(LAS unsigned*)(CM + k * 256 + (((n >> 2) ^ (k & 15)) * 16) + (n & 3) * 4) = cvt_pk_bf16(c * 0.125f, s * 0.125f); }
    __syncthreads();
    u32x4 zv[16];
    if (F.bx < 1024) { const bf16_t* Zs0 = F.BA + ((size_t)(F.bx >> 4) * 16 + (F.bx & 15)) * (4096 * 16); const int half = lane & 1, n2 = w * 8 + ((lane >> 1) & 7), n1l = (lane >> 4) & 3;
#pragma unroll
        for (int i = 0; i < 16; ++i) zv[i] = *(const u32x4*)(Zs0 + ((i * 4 + n1l) * 64 + n2) * 16 + half * 8); }
    for (int item = F.bx; item < 1024; item += F.G) {
        int lanev = lane; asm volatile("" : "+v"(lanev));
        const int frv = lanev & 15, fqv = lanev >> 4, tidv = w * 64 + lanev;
        const int bg = item >> 4, slab = item & 15;
        const size_t ibase = ((size_t)bg * 16 + slab) * (4096 * 16);
        const bf16_t* Gs = F.BB + ibase; bf16_t* Ys = F.BC + ibase;
        { const int half = lanev & 1, n2 = w * 8 + ((lanev >> 1) & 7), n1l = (lanev >> 4) & 3;
#pragma unroll
            for (int i = 0; i < 16; ++i) { const int n1 = i * 4 + n1l;
#pragma unroll
                for (int d = 0; d < 4; ++d) { const int R1 = (half * 4 + d) * 64 + n2; *(LAS unsigned*)(D + R1 * 256 + (((n1 >> 2) ^ (R1 & 15)) * 16) + (n1 & 3) * 4) = zv[i][d]; } } }
        __syncthreads();
        f32x4 aR[4][4], aI[4][4];
#pragma unroll
        for (int a = 0; a < 4; ++a)
#pragma unroll
            for (int kb = 0; kb < 4; ++kb) { aR[a][kb] = (f32x4){0.f, 0.f, 0.f, 0.f}; aI[a][kb] = (f32x4){0.f, 0.f, 0.f, 0.f}; }
#pragma unroll 1
        for (int ks = 0; ks < 4; ++ks) { const int ch = ((ks * 4 + fqv) ^ frv) * 16;
            bf16x8 Y[4], X[4];
#pragma unroll
            for (int kb = 0; kb < 4; ++kb) Y[kb] = *(const LAS bf16x8*)(CM + (kb * 16 + frv) * 256 + ch);
#pragma unroll
            for (int a = 0; a < 4; ++a) X[a] = *(const LAS bf16x8*)(D + (w * 64 + a * 16 + frv) * 256 + ch);
#pragma unroll
            for (int a = 0; a < 4; ++a) { const bf16x8 Xs = rot_negre(X[a]);
#pragma unroll
                for (int kb = 0; kb < 4; ++kb) { aR[a][kb] = __builtin_amdgcn_mfma_f32_16x16x32_bf16(X[a], Y[kb], aR[a][kb], 0, 0, 0); aI[a][kb] = __builtin_amdgcn_mfma_f32_16x16x32_bf16(Xs, Y[kb], aI[a][kb], 0, 0, 0); } } }
        __syncthreads();
#pragma unroll
        for (int a = 0; a < 4; ++a)
#pragma unroll
            for (int kb = 0; kb < 4; ++kb) { const int k1 = kb * 16 + frv, R3 = k1 * 8 + w; float o[8];
#pragma unroll
                for (int v = 0; v < 4; ++v) { const int n2 = a * 16 + fqv * 4 + v; const float ang = (float)((n2 * k1) & 4095) * (1.0f / 4096.0f);
                    const float c = __builtin_amdgcn_cosf(ang), s = __builtin_amdgcn_sinf(ang), tr = aR[a][kb][v], ti = aI[a][kb][v];
                    o[2 * v] = tr * c + ti * s; o[2 * v + 1] = ti * c - tr * s; }
                u32x4 pk; pk.x = cvt_pk_bf16(o[0], o[1]); pk.y = cvt_pk_bf16(o[2], o[3]); pk.z = cvt_pk_bf16(o[4], o[5]); pk.w = cvt_pk_bf16(o[6], o[7]);
                *(LAS u32x4*)(D + R3 * 256 + (((a * 4 + fqv) ^ f3swz(R3)) * 16)) = pk; }
        __syncthreads();
        f32x4 c3[4][4], cI[4][4];
#pragma unroll
        for (int a = 0; a < 4; ++a)
#pragma unroll
            for (int kb = 0; kb < 4; ++kb) { c3[a][kb] = (f32x4){0.f, 0.f, 0.f, 0.f}; cI[a][kb] = (f32x4){0.f, 0.f, 0.f, 0.f}; }
#pragma unroll 1
        for (int ks = 0; ks < 4; ++ks) {
            bf16x8 Y[4], X[4];
#pragma unroll
            for (int kb = 0; kb < 4; ++kb) Y[kb] = *(const LAS bf16x8*)(CM + (kb * 16 + frv) * 256 + (((ks * 4 + fqv) ^ frv) * 16));
#pragma unroll
            for (int jj = 0; jj < 4; ++jj) { const int R3 = (w * 4 + jj) * 16 + frv; X[jj] = *(const LAS bf16x8*)(D + R3 * 256 + (((ks * 4 + fqv) ^ f3swz(R3)) * 16)); }
#pragma unroll
            for (int jj = 0; jj < 4; ++jj) {
#pragma unroll
                for (int kb = 0; kb < 4; ++kb) c3[jj][kb] = __builtin_amdgcn_mfma_f32_16x16x32_bf16(X[jj], Y[kb], c3[jj][kb], 0, 0, 0);
                if (slab == 0) { const bf16x8 Xs = rot_negre(X[jj]);
#pragma unroll
                    for (int kb = 0; kb < 4; ++kb) cI[jj][kb] = __builtin_amdgcn_mfma_f32_16x16x32_bf16(Xs, Y[kb], cI[jj][kb], 0, 0, 0); } } }
        __syncthreads();
#pragma unroll
        for (int jj = 0; jj < 4; ++jj)
#pragma unroll
            for (int kb = 0; kb < 4; ++kb) { const int k1 = 2 * (w * 4 + jj) + (fqv >> 1), k2 = kb * 16 + frv, k = k1 + 64 * k2;
                u32x2 pk; pk.x = cvt_pk_bf16(c3[jj][kb][0], c3[jj][kb][1]); pk.y = cvt_pk_bf16(c3[jj][kb][2], c3[jj][kb][3]);
                *(LAS u32x2*)(D + (k + k2) * 16 + (fqv & 1) * 8) = pk;
                if (slab == 0 && (fqv & 1) == 0) *(LAS float*)(D + 98304 + k * 4) = cI[jj][kb][0]; }
        { const int it2 = (item + F.G < 1024) ? item + F.G : item;
            const bf16_t* Zn = F.BA + ((size_t)(it2 >> 4) * 16 + (it2 & 15)) * (4096 * 16); const int half = lanev & 1, n2 = w * 8 + ((lanev >> 1) & 7), n1l = (lanev >> 4) & 3;
#pragma unroll
            for (int i = 0; i < 16; ++i) zv[i] = *(const u32x4*)(Zn + ((i * 4 + n1l) * 64 + n2) * 16 + half * 8); }
        u32x4 gt[8];
#pragma unroll
        for (int i = 0; i < 8; ++i) gt[i] = *(const u32x4*)(Gs + (size_t)(tidv + NTHREADS * i) * 8);
        __syncthreads();
#pragma unroll
        for (int i = 0; i < 16; ++i) { const int q = tidv + NTHREADS * i, k = q >> 1, half = q & 1, km = (4096 - k) & 4095;
            const u32x4 a = *(const LAS u32x4*)(D + (k + (k >> 6)) * 16), bm = *(const LAS u32x4*)(D + (km + (km >> 6)) * 16);
            const u32x4 src = half ? bm : a; float vals[8];
#pragma unroll
            for (int d = 0; d < 4; ++d) { vals[2 * d] = bf_lo(src[d]); vals[2 * d + 1] = bf_hi(src[d]); }
            if (slab == 0) { if (half == 0) vals[0] = 0.5f * (bf_lo(a[0]) + bf_lo(bm[0])); else vals[0] = 0.5f * (*(const LAS float*)(D + 98304 + k * 4) + *(const LAS float*)(D + 98304 + km * 4)); }
            u32x4 o;
#pragma unroll
            for (int d = 0; d < 4; ++d) o[d] = cvt_pk_bf16(vals[2 * d] * bf_lo(gt[i & 7][d]), vals[2 * d + 1] * bf_hi(gt[i & 7][d]));
            if (i < 8) gt[i] = *(const u32x4*)(Gs + (size_t)(tidv + NTHREADS * (i + 8)) * 8);
            *(u32x4*)(Ys + (size_t)q * 8) = o; }
        __syncthreads();
    }
}

__device__ __forceinline__ int vswz(int row) { return (row & 15) ^ ((row >> 5) & 3); }
template <bool DUMMY> __device__ __forceinline__ void p5_sgu(Frame& F) {
    LAS unsigned char* VT = F.lds; LAS unsigned char* WS = F.lds + 65536;
    const int tid = F.tid, lane = F.lane, w = F.wave, fr = lane & 15, fq = lane >> 4;
    u32x4 pva[4], pvb[4]; float ps0 = 0.f, ps1 = 0.f;
    LAS f32x2* STAT = (LAS f32x2*)(F.lds + 98304);
#define SGU_VLOAD(it_) do { const int g_ = (it_) & 7, n_ = ((it_) >> 3) & 31, b_ = (it_) >> 8, r_ = b_ * 4096 + n_ * 128, c_ = g_ * 256 + (lv_ & 31) * 8; \
        _Pragma("unroll") for (int j = 0; j < 4; ++j) { const int r0 = r_ + 2 * ((w * 2 + (lv_ >> 5)) + 16 * j); \
            pva[j] = *(const u32x4*)(F.BB + (size_t)r0 * EI + c_); pvb[j] = *(const u32x4*)(F.BB + (size_t)(r0 + 1) * EI + c_); } \
        if (w < 2) { ps0 = F.vsum[r_ + w * 64 + lv_]; ps1 = F.vsq[r_ + w * 64 + lv_]; } } while (0)
#define SGU_STAT() do { if (w < 2) { const float mu_ = ps0 * (1.0f / EI); STAT[w * 64 + lane] = (f32x2){mu_, __builtin_amdgcn_rsqf(fmaxf(ps1 * (1.0f / EI) - mu_ * mu_, 0.f) + EPS)}; } } while (0)
    if (F.bx < 2048) { const int lv_ = lane; SGU_VLOAD(F.bx); SGU_STAT(); }
    __syncthreads();
    for (int item = F.bx; item < 2048; item += F.G) {
        int lanev = lane; asm volatile("" : "+v"(lanev));
        const int frv = lanev & 15, fqv = lanev >> 4, tidv = w * 64 + lanev;
        const int g = item & 7, n = (item >> 3) & 31, b = item >> 8, row0 = b * 4096 + n * 128, col0 = g * 256;
        u32x4 uu[8];
#pragma unroll
        for (int jp = 0; jp < 8; ++jp) { const size_t off = (size_t)(row0 + jp * 16 + frv) * EI + col0 + w * 32 + fqv * 8; uu[jp] = *(const u32x4*)(F.BA + off); }
#pragma unroll
        for (int i = 0; i < 4; ++i) { const int idx = tidv + NTHREADS * i, p = idx >> 4, qc = idx & 15; const float* src = F.wsp + ((size_t)g * 128 + p) * 128 + qc * 8;
            const f32x4 a0 = *(const f32x4*)src, a1 = *(const f32x4*)(src + 4);
            *(LAS u32x4*)(WS + p * 256 + ((qc ^ (p & 15)) * 16)) = pack8(a0, a1); }
        { const int c8 = tidv & 31; float gam[8], bet[8];
            { const f32x4 g0 = *(const f32x4*)(F.lng + col0 + c8 * 8), g1 = *(const f32x4*)(F.lng + col0 + c8 * 8 + 4), b0 = *(const f32x4*)(F.lnb + col0 + c8 * 8), b1 = *(const f32x4*)(F.lnb + col0 + c8 * 8 + 4);
#pragma unroll
                for (int i = 0; i < 4; ++i) { gam[i] = g0[i]; gam[4 + i] = g1[i]; bet[i] = b0[i]; bet[4 + i] = b1[i]; } }
#pragma unroll
            for (int j = 0; j < 4; ++j) { const int q = 2 * ((tidv >> 5) + 16 * j);
                const u32x4 va = pva[j], vb = pvb[j];
                const f32x4 st = *(const LAS f32x4*)(STAT + q); const float mu0 = st[0], rs0 = st[1], mu1 = st[2], rs1 = st[3];
#pragma unroll
                for (int i = 0; i < 8; ++i) { const float x0 = (i & 1) ? bf_hi(va[i >> 1]) : bf_lo(va[i >> 1]), x1 = (i & 1) ? bf_hi(vb[i >> 1]) : bf_lo(vb[i >> 1]);
                    const float y0 = (x0 - mu0) * rs0 * gam[i] + bet[i], y1 = (x1 - mu1) * rs1 * gam[i] + bet[i];
                    const int c = c8 * 8 + i, cl = c & 31, row = (c & ~31) + 16 * ((cl >> 2) & 1) + 4 * (cl >> 3) + (cl & 3);
                    *(LAS unsigned*)(VT + row * 256 + (((q >> 3) ^ vswz(row)) * 16) + (q & 7) * 2) = cvt_pk_bf16(y0, y1); } } }
        { const int it2 = (item + F.G < 2048) ? item + F.G : item; const int lv_ = lanev; SGU_VLOAD(it2); }
        __syncthreads();
        f32x4 acc[2][8];
#pragma unroll
        for (int nn = 0; nn < 2; ++nn)
#pragma unroll
            for (int jp = 0; jp < 8; ++jp) acc[nn][jp] = (f32x4){0.f, 0.f, 0.f, 0.f};
#pragma unroll 1
        for (int ks = 0; ks < 4; ++ks) { bf16x8 X[2], Y[8];
#pragma unroll
            for (int nn = 0; nn < 2; ++nn) { const int row = w * 32 + nn * 16 + frv; X[nn] = *(const LAS bf16x8*)(VT + row * 256 + (((ks * 4 + fqv) ^ vswz(row)) * 16)); }
#pragma unroll
            for (int jp = 0; jp < 8; ++jp) Y[jp] = *(const LAS bf16x8*)(WS + (jp * 16 + frv) * 256 + (((ks * 4 + fqv) ^ frv) * 16));
#pragma unroll
            for (int nn = 0; nn < 2; ++nn)
#pragma unroll
                for (int jp = 0; jp < 8; ++jp) acc[nn][jp] = __builtin_amdgcn_mfma_f32_16x16x32_bf16(X[nn], Y[jp], acc[nn][jp], 0, 0, 0); }
#pragma unroll
        for (int jp = 0; jp < 8; ++jp) { const int p = jp * 16 + frv; const float bs = F.bsp[g * 128 + p]; u32x4 o;
#pragma unroll
            for (int d = 0; d < 4; ++d) { const f32x4 a = acc[d >> 1][jp]; const float m0 = a[(d & 1) * 2] + bs, m1 = a[(d & 1) * 2 + 1] + bs;
                o[d] = cvt_pk_bf16(bf_lo(uu[jp][d]) * m0, bf_hi(uu[jp][d]) * m1); }
            { const size_t oo = (size_t)(row0 + p) * EI + col0 + w * 32 + fqv * 8; if (DUMMY) *(u32x4*)(F.HB + (oo & ((size_t)MROWS * DM - 1))) = o; else *(u32x4*)(F.BA + oo) = o; } }
        SGU_STAT();
        __syncthreads();
    }
}

#undef SGU_VLOAD
#undef SGU_STAT
__device__ __forceinline__ void p7_final(Frame& F) {
    const int gw = F.bx * NWAVES + F.wave, NGW = F.G * NWAVES;
    const f32x4 g0 = *((const f32x4*)F.nf + 2 * F.lane), g1 = *((const f32x4*)F.nf + 2 * F.lane + 1), g2 = *((const f32x4*)F.nf + 128 + 2 * F.lane), g3 = *((const f32x4*)F.nf + 128 + 2 * F.lane + 1);
    for (int m0 = gw * 2; m0 < MROWS; m0 += NGW * 2) {
        u32x4 a[2], b[2]; float rstd[2];
#pragma unroll
        for (int r = 0; r < 2; ++r) { const u32x4* xr = (const u32x4*)(F.HB + (size_t)(m0 + r) * DM); a[r] = xr[F.lane]; b[r] = xr[64 + F.lane]; rstd[r] = __builtin_amdgcn_rsqf(F.ss2[m0 + r] * (1.0f / DM) + EPS); }
#pragma unroll
        for (int r = 0; r < 2; ++r) { f32x4* o = (f32x4*)(F.out + (size_t)(m0 + r) * DM); const float rs = rstd[r];
            o[2 * F.lane]           = (f32x4){bf_lo(a[r].x), bf_hi(a[r].x), bf_lo(a[r].y), bf_hi(a[r].y)} * g0 * rs;
            o[2 * F.lane + 1]       = (f32x4){bf_lo(a[r].z), bf_hi(a[r].z), bf_lo(a[r].w), bf_hi(a[r].w)} * g1 * rs;
            o[128 + 2 * F.lane]     = (f32x4){bf_lo(b[r].x), bf_hi(b[r].x), bf_lo(b[r].y), bf_hi(b[r].y)} * g2 * rs;
            o[128 + 2 * F.lane + 1] = (f32x4){bf_lo(b[r].z), bf_hi(b[r].z), bf_lo(b[r].w), bf_hi(b[r].w)} * g3 * rs; }
    }
}

__global__ void __launch_bounds__(NTHREADS, 2) fwd_megakernel(Args args) {
    extern __shared__ __attribute__((aligned(16))) unsigned char lds_raw[];
    cg::grid_group grid = cg::this_grid();
    Frame F;
    F.lds = (LAS unsigned char*)lds_raw; F.tid = threadIdx.x; F.lane = F.tid & 63; F.wave = __builtin_amdgcn_readfirstlane(F.tid >> 6); F.G = gridDim.x; F.bx = blockIdx.x;
    F.x = args.in[0]; F.n0 = args.in[1]; F.win0 = args.in[2]; F.wout0 = args.in[3]; F.n1 = args.in[4]; F.win1 = args.in[5]; F.lng = args.in[6]; F.lnb = args.in[7];
    F.wsp = args.in[8]; F.bsp = args.in[9]; F.wout1 = args.in[10]; F.nf = args.in[11]; F.out = args.out;
    unsigned char* ws = args.ws;
    F.ss1 = (float*)(ws + WS_SS1); F.vsum = (float*)(ws + WS_VSUM); F.vsq = (float*)(ws + WS_VSQ); F.ss2 = (float*)(ws + WS_SS2);
    F.W0t = (bf16_t*)(ws + WS_W0T); F.Wo0t = (bf16_t*)(ws + WS_WO0T); F.W1t = (bf16_t*)(ws + WS_W1T); F.Wo1t = (bf16_t*)(ws + WS_WO1T);
    F.HB = (bf16_t*)(ws + WS_HB); F.BA = (bf16_t*)(ws + WS_BUFA); F.BB = (bf16_t*)(ws + WS_BUFB); F.BC = (bf16_t*)(ws + WS_BUFC);

    volatile LAS unsigned* MISC = (volatile LAS unsigned*)(F.lds + MISC_OFF);
    if (F.tid < 32) MISC[F.tid] = 0u;
    __syncthreads();
#ifdef PROBE_A
    unsigned long long ts[9]; int nts = 0;
#define STAMP() do { ts[nts++] = __builtin_amdgcn_s_memrealtime(); } while (0)
#else
#define STAMP() do { } while (0)
#endif
    XcdBarrier bar = xcd_barrier_post((unsigned*)(ws + WS_BAR), MISC);
    if (ws == nullptr) grid.sync();
    STAMP();
    p0_prep(F);
#if defined(DUP) && (DUP & 1)
    p0_prep(F);
#endif
    xcd_barrier(bar); STAMP();
    { pg8::Gemm g{F.HB, F.W0t, MROWS, 4096, DM}; pg8::StaticOrder S; S.init(MROWS, 4096, F.G, F.bx); Epi1 E{F.BA, F.BB};
      pg8::gemm_phase<Epi1, false>(F.lds, g, S, E);
#if defined(DUP) && (DUP & 2)
      __syncthreads(); pg8::gemm_phase<Epi1, false>(F.lds, g, S, E);
#endif
    }
    xcd_barrier(bar); STAMP();
    p2_fft(F);
#if defined(DUP) && (DUP & 4)
    p2_fft(F);
#endif
    xcd_barrier(bar); STAMP();
    { pg8::Gemm g{F.BC, F.Wo0t, MROWS, DM, EI}; pg8::StaticOrder S; S.init(MROWS, DM, F.G, F.bx); EpiRes<true> E{F.x, F.HB, F.ss1};
#if defined(DUP) && (DUP & 8)
      { EpiRes<true> E2{F.x, F.HB, (float*)(ws + 640 * 1024)}; pg8::gemm_phase<EpiRes<true>, true>(F.lds, g, S, E2); __syncthreads(); }
#endif
      pg8::gemm_phase<EpiRes<true>, true>(F.lds, g, S, E); }
    xcd_barrier(bar); STAMP();
    { pg8::Gemm g{F.HB, F.W1t, MROWS, 6144, DM}; pg8::StaticOrder S; S.init(MROWS, 6144, F.G, F.bx); Epi3 E{F.ss1, F.BA, F.BB, F.vsum, F.vsq};
#if defined(DUP) && (DUP & 16)
      { Epi3 E2{F.ss1, F.BA, F.BB, (float*)(ws + 640 * 1024), (float*)(ws + 768 * 1024)}; pg8::gemm_phase<Epi3, false>(F.lds, g, S, E2); __syncthreads(); }
#endif
      pg8::gemm_phase<Epi3, false>(F.lds, g, S, E); }
    xcd_barrier(bar); STAMP();
#if defined(DUP) && (DUP & 32)
    p5_sgu<true>(F);
#endif
    p5_sgu<false>(F);
    xcd_barrier(bar); STAMP();
    { pg8::Gemm g{F.BA, F.Wo1t, MROWS, DM, EI}; pg8::StaticOrder S; S.init(MROWS, DM, F.G, F.bx); EpiRes<false> E{nullptr, F.HB, F.ss2};
      pg8::gemm_phase<EpiRes<false>, false>(F.lds, g, S, E); }
    xcd_barrier(bar); STAMP();
    p7_final(F);
#ifdef PROBE_A
    xcd_barrier(bar); STAMP();
    if (F.bx == 0) { const float ta = (float)(ts[PROBE_A + 1] - ts[PROBE_A]) * 0.01f, tb = (float)(ts[PROBE_B + 1] - ts[PROBE_B]) * 0.0001f;
        for (int i = 1 + F.tid; i < MROWS * DM / 16; i += NTHREADS) F.out[i] += tb;
        if (F.tid == 0) F.out[0] = ta; }
#endif
}

extern "C" void kernel_launch(void* const* d_in, const int* in_sizes, int n_in, void* d_out, int out_size, void* d_ws, size_t ws_size, hipStream_t stream) {
    static int grid = 0;
    if (!grid) {
        if (n_in != 12 || in_sizes[0] != MROWS * DM || out_size != MROWS * DM || ws_size < WS_END) {
            fprintf(stderr, "kernel_launch: unexpected problem (n_in %d, in0 %d, out %d, ws %zu); nothing launched\n", n_in, in_sizes[0], out_size, ws_size); grid = -1; return; }
        int dev = 0, cus = 0, per_cu = 0;
        if (hipGetDevice(&dev) != hipSuccess || hipDeviceGetAttribute(&cus, hipDeviceAttributeMultiprocessorCount, dev) != hipSuccess) { grid = -1; return; }
        if (hipFuncSetAttribute((const void*)fwd_megakernel, hipFuncAttributeMaxDynamicSharedMemorySize, LDS_BYTES) != hipSuccess) { fprintf(stderr, "kernel_launch: hipFuncSetAttribute failed\n"); grid = -1; return; }
        if (hipOccupancyMaxActiveBlocksPerMultiprocessor(&per_cu, (const void*)fwd_megakernel, NTHREADS, LDS_BYTES) != hipSuccess || per_cu < 1) per_cu = 1;
        grid = cus * per_cu;
    }
    if (grid < 0) return;
    if (hipMemsetAsync((char*)d_ws + WS_BAR, 0, XCD_BAR_WORDS * 4, stream) != hipSuccess) { fprintf(stderr, "kernel_launch: hipMemsetAsync failed\n"); return; }
    Args a{};
    for (int i = 0; i < 12; ++i) a.in[i] = (const float*)d_in[i];
    a.out = (float*)d_out; a.ws = (unsigned char*)d_ws;
    void* kargs[] = {&a};
    hipError_t e = hipLaunchCooperativeKernel((const void*)fwd_megakernel, dim3(grid), dim3(NTHREADS), kargs, LDS_BYTES, stream);
    if (e != hipSuccess) fprintf(stderr, "kernel_launch: cooperative launch failed: %s (grid %d)\n", hipGetErrorString(e), grid);
}
```
